# Optimizing an MI355X kernel written in HIP

```python
import jax
import jax.numpy as jnp
from jax import lax
import numpy as np

D_MODEL = 2048
BATCH = 16
SEQ = 2048
DEPTH = 1

HEAD_DIM = 64
MIX_WIDTH = D_MODEL
A_WIDTH = MIX_WIDTH // 2
B_WIDTH = MIX_WIDTH - A_WIDTH
A_HEADS = A_WIDTH // HEAD_DIM
B_Q_HEADS = B_WIDTH // HEAD_DIM
B_KV_HEADS = max(1, B_Q_HEADS // 8)
B_GROUP = B_Q_HEADS // B_KV_HEADS
KV_B_WIDTH = B_KV_HEADS * HEAD_DIM
QKV_WIDTH = 3 * A_WIDTH + B_WIDTH + 2 * KV_B_WIDTH
DILATED_PATTERNS = ((128, 1), (512, 4), (2048, 16))
SWA_WINDOW = 128
BLOCK = 128
D_FF = ((8 * D_MODEL // 3 + 255) // 256) * 256
PLE_DIM = 256
ALIBI_MAX_BIAS = 8.0
EPS = 1e-6

kernel_name = 'hybrid_dilated_swa_macaron_layer'


def rmsnorm(x, g):
    xf = x.astype(jnp.float32)
    y = xf * lax.rsqrt(jnp.mean(xf * xf, axis=-1, keepdims=True) + EPS)
    return (y * g.astype(jnp.float32)).astype(x.dtype)


def swiglu(x, w_gate, w_up, w_down):
    return (jax.nn.silu(x @ w_gate) * (x @ w_up)) @ w_down


def alibi_slopes(n):
    return jnp.exp2(-ALIBI_MAX_BIAS * (jnp.arange(n, dtype=jnp.float32) + 1.0) / n)


def banded_attention(q, k, v, slopes, dist_scale, window, sinks=None):
    n, hk, g, length, dh = q.shape
    nb = -(-length // BLOCK)
    pad = nb * BLOCK - length
    qb = jnp.pad(q, ((0, 0), (0, 0), (0, 0), (0, pad), (0, 0))).reshape(n, hk, g, nb, BLOCK, dh)

    def band(t):
        t = jnp.pad(t, ((0, 0), (0, 0), (BLOCK, pad), (0, 0))).reshape(n, hk, nb + 1, BLOCK, dh)
        return jnp.concatenate([t[:, :, :-1], t[:, :, 1:]], axis=3)

    kb, vb = band(k), band(v)
    s = jnp.einsum('nhgbqd,nhbkd->nhgbqk', qb, kb).astype(jnp.float32) * (dh ** -0.5)
    qi = jnp.arange(BLOCK)[:, None]
    kj = jnp.arange(2 * BLOCK)[None, :]
    rel = qi + BLOCK - kj
    blk = jnp.arange(nb)[:, None, None]
    valid = (rel >= 0) & (rel <= window) & ((blk > 0) | (kj >= BLOCK))
    bias = -slopes.astype(jnp.float32)[:, :, None, None, None] * (dist_scale * rel).astype(jnp.float32)
    s = jnp.where(valid, s + bias, -jnp.inf)
    m = jnp.max(s, axis=-1, keepdims=True)
    if sinks is not None:
        sk = sinks.astype(jnp.float32)[:, :, None, None, None]
        m = jnp.maximum(m, sk)
    e = jnp.exp(s - m)
    denom = jnp.sum(e, axis=-1, keepdims=True)
    if sinks is not None:
        denom = denom + jnp.exp(sk - m)
    o = jnp.einsum('nhgbqk,nhbkd->nhgbqd', e, vb.astype(jnp.float32)) / denom
    lse = (m + jnp.log(denom))[..., 0]
    o = o.reshape(n, hk, g, nb * BLOCK, dh)[:, :, :, :length]
    lse = lse.reshape(n, hk, g, nb * BLOCK)[:, :, :, :length]
    return o, lse


def dilated_attention(q, k, v, slopes):
    bsz, seq, nh, dh = q.shape
    outs, lses = [], []
    for window, dil in DILATED_PATTERNS:
        sub = seq // dil

        def fold(t):
            return t.reshape(bsz, sub, dil, nh, dh).transpose(0, 2, 3, 1, 4).reshape(bsz * dil, nh, sub, dh)

        o, lse = banded_attention(fold(q)[:, :, None], fold(k), fold(v), slopes[:, None], dil, window // dil)
        outs.append(o[:, :, 0].reshape(bsz, dil, nh, sub, dh).transpose(0, 3, 1, 2, 4).reshape(bsz, seq, nh, dh))
        lses.append(lse[:, :, 0].reshape(bsz, dil, nh, sub).transpose(0, 3, 1, 2).reshape(bsz, seq, nh))
    w = jax.nn.softmax(jnp.stack(lses, axis=0), axis=0)
    out = jnp.sum(w[..., None] * jnp.stack(outs, axis=0), axis=0)
    return out.astype(q.dtype)


def sink_swa_gqa(q, k, v, slopes, sinks):
    bsz, seq, _ = q.shape
    qh = q.reshape(bsz, seq, B_KV_HEADS, B_GROUP, HEAD_DIM).transpose(0, 2, 3, 1, 4)
    kh = k.reshape(bsz, seq, B_KV_HEADS, HEAD_DIM).transpose(0, 2, 1, 3)
    vh = v.reshape(bsz, seq, B_KV_HEADS, HEAD_DIM).transpose(0, 2, 1, 3)
    o, _ = banded_attention(qh, kh, vh, slopes, 1, SWA_WINDOW - 1, sinks)
    return o.transpose(0, 3, 1, 2, 4).reshape(bsz, seq, B_WIDTH).astype(q.dtype)


def setup_inputs(seed: int = 0) -> dict:
    key = jax.random.key(seed)
    keys = jax.random.split(key, 32)
    ctr = [0]

    def nk():
        ctr[0] += 1
        return keys[ctr[0] - 1]

    def w(shape, fan_in):
        return jax.random.normal(nk(), (DEPTH,) + shape, jnp.float32) * (fan_in ** -0.5)

    def gain(n):
        return 1.0 + 0.05 * jax.random.normal(nk(), (DEPTH, n), jnp.float32)

    def small(shape, scale):
        return scale * jax.random.normal(nk(), (DEPTH,) + shape, jnp.float32)

    return {
        'x': jax.random.normal(nk(), (BATCH, SEQ, D_MODEL), jnp.float32),
        'p': jax.random.normal(nk(), (DEPTH, BATCH, SEQ, PLE_DIM), jnp.float32),
        'g_ffn1_pre': gain(D_MODEL),
        'w_ffn1_gate': w((D_MODEL, D_FF), D_MODEL),
        'w_ffn1_up': w((D_MODEL, D_FF), D_MODEL),
        'w_ffn1_down': w((D_FF, D_MODEL), D_FF),
        'g_ffn1_post': gain(D_MODEL),
        'g_mix_pre': gain(D_MODEL),
        'w_qkv': w((D_MODEL, QKV_WIDTH), D_MODEL),
        'b_qkv': small((QKV_WIDTH,), 0.02),
        'attn_sinks': small((B_KV_HEADS, B_GROUP), 1.0),
        'g_out_a': gain(A_WIDTH),
        'g_out_b': gain(B_WIDTH),
        'w_o': w((MIX_WIDTH, D_MODEL), MIX_WIDTH),
        'b_o': small((D_MODEL,), 0.02),
        'g_mix_post': gain(D_MODEL),
        'g_ffn2_pre': gain(D_MODEL),
        'w_ffn2_gate': w((D_MODEL, D_FF), D_MODEL),
        'w_ffn2_up': w((D_MODEL, D_FF), D_MODEL),
        'w_ffn2_down': w((D_FF, D_MODEL), D_FF),
        'g_ffn2_post': gain(D_MODEL),
        'g_ple_pre': gain(D_MODEL),
        'w_ple_gate': w((D_MODEL, D_MODEL), D_MODEL),
        'w_ple_proj': w((PLE_DIM, D_MODEL), PLE_DIM),
        'g_ple_post': gain(D_MODEL),
    }


def reference(x, p, g_ffn1_pre, w_ffn1_gate, w_ffn1_up, w_ffn1_down, g_ffn1_post,
              g_mix_pre, w_qkv, b_qkv, attn_sinks, g_out_a, g_out_b, w_o, b_o, g_mix_post,
              g_ffn2_pre, w_ffn2_gate, w_ffn2_up, w_ffn2_down, g_ffn2_post,
              g_ple_pre, w_ple_gate, w_ple_proj, g_ple_post):
    bsz, seq, _ = x.shape
    slopes = alibi_slopes(A_HEADS + B_Q_HEADS)
    slopes_a = slopes[0::2]
    slopes_b = slopes[1::2].reshape(B_KV_HEADS, B_GROUP)
    splits = [A_WIDTH, 2 * A_WIDTH, 3 * A_WIDTH, 3 * A_WIDTH + B_WIDTH, 3 * A_WIDTH + B_WIDTH + KV_B_WIDTH]
    h = x
    for i in range(DEPTH):
        f = swiglu(rmsnorm(h, g_ffn1_pre[i]), w_ffn1_gate[i], w_ffn1_up[i], w_ffn1_down[i])
        h = h + 0.5 * rmsnorm(f, g_ffn1_post[i])
        u = rmsnorm(h, g_mix_pre[i])
        z = u @ w_qkv[i] + b_qkv[i]
        qa, ka, va, qb, kb, vb = jnp.split(z, splits, axis=-1)
        qa = qa.reshape(bsz, seq, A_HEADS, HEAD_DIM)
        ka = ka.reshape(bsz, seq, A_HEADS, HEAD_DIM)
        va = va.reshape(bsz, seq, A_HEADS, HEAD_DIM)
        oa = dilated_attention(qa, ka, va, slopes_a).reshape(bsz, seq, A_WIDTH)
        ob = sink_swa_gqa(qb, kb, vb, slopes_b, attn_sinks[i])
        o = jnp.concatenate([rmsnorm(oa, g_out_a[i]), rmsnorm(ob, g_out_b[i])], axis=-1)
        o = o @ w_o[i] + b_o[i]
        h = h + rmsnorm(o, g_mix_post[i])
        f = swiglu(rmsnorm(h, g_ffn2_pre[i]), w_ffn2_gate[i], w_ffn2_up[i], w_ffn2_down[i])
        h = h + 0.5 * rmsnorm(f, g_ffn2_post[i])
        gate = jax.nn.sigmoid(rmsnorm(h, g_ple_pre[i]) @ w_ple_gate[i])
        e = p[i] @ w_ple_proj[i]
        h = h + rmsnorm(gate * e, g_ple_post[i])
    return h
```

```cpp
#include <hip/hip_runtime.h>
#include <hip/hip_cooperative_groups.h>
#include <cstdio>
#include <cstdint>
namespace cg = cooperative_groups;

#ifndef MK_N_LAUNCHES
#define MK_N_LAUNCHES 1
#endif

#ifndef DUP_MASK
#define DUP_MASK 0
#endif
#define LAS __attribute__((address_space(3)))
typedef unsigned short bf16_t;
typedef short bf16x8 __attribute__((ext_vector_type(8)));
typedef float f32x4 __attribute__((ext_vector_type(4)));
typedef float f32x2 __attribute__((ext_vector_type(2)));
typedef unsigned u32x4 __attribute__((ext_vector_type(4)));
typedef unsigned u32x2 __attribute__((ext_vector_type(2)));

constexpr int DM = 2048, BATCH = 16, SEQ = 2048, M = BATCH * SEQ;
constexpr int FF = 5632, NQKV = 4352, PLE = 256, AW = 1024;
constexpr float EPS = 1e-6f;
constexpr float LOG2E = 1.4426950408889634f, LN2 = 0.6931471805599453f;

constexpr size_t MiB = 1u << 20;
constexpr size_t WS_W1GU = 1 * MiB;
constexpr size_t WS_W1D  = WS_W1GU + 44 * MiB;
constexpr size_t WS_W2GU = WS_W1D + 22 * MiB;
constexpr size_t WS_W2D  = WS_W2GU + 44 * MiB;
constexpr size_t WS_WQKV = WS_W2D + 22 * MiB;
constexpr size_t WS_WO   = WS_WQKV + 17 * MiB;
constexpr size_t WS_WG   = WS_WO + 8 * MiB;
constexpr size_t WS_WP   = WS_WG + 8 * MiB;
constexpr size_t WS_XN   = WS_WP + 1 * MiB;
constexpr size_t WS_ACT  = WS_XN + 128 * MiB;
constexpr size_t WS_Z    = WS_ACT;
constexpr size_t WS_OB   = WS_ACT + 272 * MiB;
constexpr size_t WS_F    = WS_ACT + 352 * MiB;
constexpr size_t WS_OA   = WS_F;
constexpr size_t WS_LSE  = WS_F + 192 * MiB;
constexpr size_t WS_PB   = WS_LSE + 6 * MiB;
constexpr size_t WS_E    = WS_PB + 16 * MiB;
constexpr size_t WS_END  = WS_E + 128 * MiB;
static_assert(WS_END <= 1024 * MiB, "workspace map");

constexpr int RING_BYTES = 131072;
constexpr int LDS_BYTES = 147456;

__device__ __forceinline__ unsigned cvt_pk_bf16(float lo, float hi) { unsigned r; asm volatile("v_cvt_pk_bf16_f32 %0, %1, %2" : "=v"(r) : "v"(lo), "v"(hi)); return r; }
__device__ __forceinline__ float bf_lo(unsigned w) { return __builtin_bit_cast(float, w << 16); }
__device__ __forceinline__ float bf_hi(unsigned w) { return __builtin_bit_cast(float, w & 0xffff0000u); }
template <int CTRL> __device__ __forceinline__ float dpp_mov(float x) { return __builtin_bit_cast(float, __builtin_amdgcn_mov_dpp(__builtin_bit_cast(int, x), CTRL, 0xf, 0xf, true)); }
__device__ __forceinline__ float wave_sum(float v) {
    v += dpp_mov<0xB1>(v); v += dpp_mov<0x4E>(v); v += dpp_mov<0x141>(v); v += dpp_mov<0x140>(v);
    auto s = __builtin_amdgcn_permlane16_swap(__float_as_uint(v), __float_as_uint(v), false, false);
    v = __uint_as_float(s[0]) + __uint_as_float(s[1]);
    auto t = __builtin_amdgcn_permlane32_swap(__float_as_uint(v), __float_as_uint(v), false, false);
    return __uint_as_float(t[0]) + __uint_as_float(t[1]);
}

namespace pg8 {
constexpr int BM = 256, BK = 64, HALF = 128, HTB = HALF * BK * 2, STAGE_BYTES = 8 * HTB, NXCD = 8, WGM = 4;
__host__ __device__ __forceinline__ int lds_byte(int r, int c) { const int st = (r >> 4) * 2 + (c >> 5), rr = r & 15, cc = c & 31, ob = rr * 64 + cc * 2; return st * 1024 + (ob ^ (((ob >> 9) & 1) << 5)); }
__host__ __device__ __forceinline__ void stage_rc(int b, int& R, int& C) { const int st = b / 1024, sb = b % 1024, swz = sb ^ (((sb >> 9) & 1) << 5); R = (st >> 1) * 16 + swz / 64; C = (st & 1) * 32 + (swz % 64) / 2; }
__host__ __device__ __forceinline__ int perm32(int rho) { const int n = rho >> 4, i = rho & 15; return 8 * (i >> 2) + 4 * n + (i & 3); }

struct Unit { int pm, pn; };
struct Gemm { const bf16_t* A; const bf16_t* Bt; int M, N, K; };

struct StaticOrder {
    int nM, nN, nwg, G, c;
    __host__ __device__ void init(int M_, int N_, int G_, int c_) { nM = M_ / BM; nN = N_ / BM; nwg = nM * nN; G = G_; c = c_; }
    __host__ __device__ bool next(int i, Unit& u) const {
        const long L = (long)i * G + c; if (L >= nwg) return false;
        int wgid = (int)L; { const int q = nwg / NXCD, r = nwg % NXCD, xcd = wgid % NXCD, off = wgid / NXCD; wgid = (xcd < r ? xcd * (q + 1) : r * (q + 1) + (xcd - r) * q) + off; }
        const int nig = WGM * nN, gid = wgid / nig, fm = gid * WGM, gsz = (nM - fm) < WGM ? (nM - fm) : WGM;
        u.pm = fm + ((wgid % nig) % gsz); u.pn = (wgid % nig) / gsz; return true;
    }
};

__device__ __forceinline__ void prefetch_row_sums(const float* ss, const Unit& u, int wr, int fr, float (&raw)[8]) {
    if (ss) { const int row0 = u.pm * BM + wr * 64 + fr;
#pragma unroll
        for (int i = 0; i < 8; ++i) raw[i] = ss[row0 + (i >> 2) * HALF + (i & 3) * 16]; }
}
__device__ __forceinline__ void load_row_scales(const float* ss, const float (&raw)[8], float (&rs)[2][4]) {
#pragma unroll
    for (int ai = 0; ai < 2; ++ai)
#pragma unroll
        for (int m = 0; m < 4; ++m) rs[ai][m] = ss ? 1.0f / sqrtf(raw[ai * 4 + m] * (1.0f / DM) + EPS) : 1.0f;
}
struct EpiBf16 {
    bf16_t* O; int ldc; const float* bias; const float* ss;
    __device__ __forceinline__ void operator()(const f32x4 (&acc)[2][2][4][2], const Unit& u, int wr, int wc, int fr, int fq, const float (&raw)[8]) const {
        const int row0 = u.pm * BM + wr * 64 + fr; const int col0 = u.pn * BM + wc * 32 + 8 * fq;
        float rs[2][4]; load_row_scales(ss, raw, rs);
        f32x4 bv[2][2];
#pragma unroll
        for (int bj = 0; bj < 2; ++bj)
#pragma unroll
            for (int n = 0; n < 2; ++n) bv[bj][n] = bias ? *(const f32x4*)(bias + col0 + bj * HALF + 4 * n) : (f32x4){0.f, 0.f, 0.f, 0.f};
#pragma unroll
        for (int ai = 0; ai < 2; ++ai)
#pragma unroll
            for (int m = 0; m < 4; ++m) { bf16_t* rowp = O + (size_t)(row0 + ai * HALF + m * 16) * ldc + col0;
#pragma unroll
                for (int bj = 0; bj < 2; ++bj) { const f32x4 v0 = acc[ai][bj][m][0] * rs[ai][m] + bv[bj][0], v1 = acc[ai][bj][m][1] * rs[ai][m] + bv[bj][1];
                    u32x4 w; w.x = cvt_pk_bf16(v0[0], v0[1]); w.y = cvt_pk_bf16(v0[2], v0[3]); w.z = cvt_pk_bf16(v1[0], v1[1]); w.w = cvt_pk_bf16(v1[2], v1[3]);
                    *(u32x4*)(rowp + bj * HALF) = w; } }
    }
};
__device__ __forceinline__ f32x2 silu_pk(f32x2 g, f32x2 u, float rl, float ir2) {
    const f32x2 t = g * rl;
    f32x2 e; e.x = __builtin_amdgcn_exp2f(t.x); e.y = __builtin_amdgcn_exp2f(t.y);
    const f32x2 d = e * ir2 + ir2;
    f32x2 q; q.x = __builtin_amdgcn_rcpf(d.x); q.y = __builtin_amdgcn_rcpf(d.y);
    return (g * u) * q;
}
struct EpiSwiGLU {
    bf16_t* O; int ldc; const float* ss;
    __device__ __forceinline__ void operator()(const f32x4 (&acc)[2][2][4][2], const Unit& u, int wr, int wc, int fr, int fq, const float (&raw)[8]) const {
        const int row0 = u.pm * BM + wr * 64 + fr; const int col0 = u.pn * HALF + wc * 32 + 8 * fq;
#pragma unroll
        for (int ai = 0; ai < 2; ++ai)
#pragma unroll
            for (int m = 0; m < 4; ++m) { bf16_t* rowp = O + (size_t)(row0 + ai * HALF + m * 16) * ldc + col0;
                const float ir2 = ss ? raw[ai * 4 + m] * (1.0f / DM) + EPS : 1.0f; const float rl = -LOG2E / sqrtf(ir2);
                const f32x4 g0 = acc[ai][0][m][0], g1 = acc[ai][0][m][1], u0 = acc[ai][1][m][0], u1 = acc[ai][1][m][1];
                const f32x2 a = silu_pk((f32x2){g0[0], g0[1]}, (f32x2){u0[0], u0[1]}, rl, ir2), b = silu_pk((f32x2){g0[2], g0[3]}, (f32x2){u0[2], u0[3]}, rl, ir2);
                const f32x2 c = silu_pk((f32x2){g1[0], g1[1]}, (f32x2){u1[0], u1[1]}, rl, ir2), d = silu_pk((f32x2){g1[2], g1[3]}, (f32x2){u1[2], u1[3]}, rl, ir2);
                u32x4 w; w.x = cvt_pk_bf16(a.x, a.y); w.y = cvt_pk_bf16(b.x, b.y); w.z = cvt_pk_bf16(c.x, c.y); w.w = cvt_pk_bf16(d.x, d.y);
                *(u32x4*)rowp = w; }
    }
};
__device__ __forceinline__ float sig_mul(float a, float e) { return e * __builtin_amdgcn_rcpf(1.0f + __builtin_amdgcn_exp2f(-a * LOG2E)); }
struct EpiSigMul {
    bf16_t* O; const bf16_t* E; int ldc; const float* ss;
    __device__ __forceinline__ void operator()(const f32x4 (&acc)[2][2][4][2], const Unit& u, int wr, int wc, int fr, int fq, const float (&raw)[8]) const {
        const int row0 = u.pm * BM + wr * 64 + fr; const int col0 = u.pn * BM + wc * 32 + 8 * fq;
        float rs[2][4]; load_row_scales(ss, raw, rs);
#pragma unroll
        for (int ai = 0; ai < 2; ++ai) {
            u32x4 ev[4][2];
#pragma unroll
            for (int m = 0; m < 4; ++m)
#pragma unroll
                for (int bj = 0; bj < 2; ++bj) ev[m][bj] = *(const u32x4*)(E + (size_t)(row0 + ai * HALF + m * 16) * ldc + col0 + bj * HALF);
            asm volatile("" ::: "memory");
#pragma unroll
            for (int m = 0; m < 4; ++m) { const size_t off = (size_t)(row0 + ai * HALF + m * 16) * ldc + col0;
#pragma unroll
                for (int bj = 0; bj < 2; ++bj) { const f32x4 v0 = acc[ai][bj][m][0] * rs[ai][m], v1 = acc[ai][bj][m][1] * rs[ai][m]; const u32x4 e = ev[m][bj];
                    u32x4 w; w.x = cvt_pk_bf16(sig_mul(v0[0], bf_lo(e.x)), sig_mul(v0[1], bf_hi(e.x))); w.y = cvt_pk_bf16(sig_mul(v0[2], bf_lo(e.y)), sig_mul(v0[3], bf_hi(e.y)));
                    w.z = cvt_pk_bf16(sig_mul(v1[0], bf_lo(e.z)), sig_mul(v1[1], bf_hi(e.z))); w.w = cvt_pk_bf16(sig_mul(v1[2], bf_lo(e.w)), sig_mul(v1[3], bf_hi(e.w)));
                    *(u32x4*)(O + off + bj * HALF) = w; } }
            asm volatile("" ::: "memory");
        }
    }
};

template <class Epi>
__device__ __forceinline__ void gemm_phase(LAS unsigned char* lds, const Gemm g, const StaticOrder& S, const Epi& E) {
    const int tid = threadIdx.x, wid = __builtin_amdgcn_readfirstlane(tid >> 6), lane = tid & 63, wr = wid >> 2, wc = wid & 3, fr = lane & 15, fq = lane >> 4;
    const int K = g.K, nt = K / BK;
    unsigned voffA[2], voffB[2];
#pragma unroll
    for (int i = 0; i < 2; ++i) { int R, C; stage_rc(tid * 16 + i * 8192, R, C); const int Rb = (R & ~31) + perm32(R & 31);
        voffA[i] = (unsigned)(R * K + C) * 2u; voffB[i] = (unsigned)(Rb * K + C) * 2u; }
    const size_t kstep = (size_t)(BK * 2);
    const size_t hstep = (size_t)HALF * K * 2;
    const size_t tstep = 2 * hstep;
    const unsigned ldsw = (unsigned)wid * 1024u;
    const int aoff = lds_byte(wr * 64 + fr, fq * 8), boff = lds_byte(wc * 32 + fr, fq * 8);
#define PG8_SA(b, h) (((b) * 2 + (h)) * HTB)
#define PG8_SB(b, h) ((4 + (b) * 2 + (h)) * HTB)
#define PG8_STAGE(bufoff, gbase, voff) do { _Pragma("unroll") for (int _i = 0; _i < 2; ++_i) \
        __builtin_amdgcn_global_load_lds((const unsigned*)((const char*)(gbase) + (voff)[_i]), (LAS unsigned*)(lds + (bufoff) + ldsw + _i * 8192), 16, 0, 0); } while (0)
#define PG8_LDA(dst, b, h) do { _Pragma("unroll") for (int m = 0; m < 4; ++m) _Pragma("unroll") for (int k = 0; k < 2; ++k) dst[m][k] = *(const LAS bf16x8*)(lds + PG8_SA(b, h) + aoff + m * 2048 + k * 1024); } while (0)
#define PG8_LDB(dst, b, h) do { _Pragma("unroll") for (int n = 0; n < 2; ++n) _Pragma("unroll") for (int k = 0; k < 2; ++k) dst[n][k] = *(const LAS bf16x8*)(lds + PG8_SB(b, h) + boff + n * 2048 + k * 1024); } while (0)
#define PG8_MMA(ai, bj, At, Bt) do { __builtin_amdgcn_s_setprio(1); _Pragma("unroll") for (int m = 0; m < 4; ++m) _Pragma("unroll") for (int n = 0; n < 2; ++n) _Pragma("unroll") for (int k = 0; k < 2; ++k) \
        acc[ai][bj][m][n] = __builtin_amdgcn_mfma_f32_16x16x32_bf16(Bt[n][k], At[m][k], acc[ai][bj][m][n], 0, 0, 0); __builtin_amdgcn_s_setprio(0); } while (0)
#define PG8_WAIT_V(n) asm volatile("s_waitcnt vmcnt(" #n ")" ::: "memory")
#define PG8_WAIT_L(n) asm volatile("s_waitcnt lgkmcnt(" #n ")" ::: "memory")
#define PG8_BAR __builtin_amdgcn_s_barrier()
#define PG8_SCHED __builtin_amdgcn_sched_barrier(0)
    Unit cur, nxt; int ui = 0;
    if (!S.next(0, cur)) return;
    f32x4 acc[2][2][4][2];
#pragma unroll
    for (int a = 0; a < 2; ++a)
#pragma unroll
        for (int b = 0; b < 2; ++b)
#pragma unroll
            for (int m = 0; m < 4; ++m)
#pragma unroll
                for (int n = 0; n < 2; ++n) acc[a][b][m][n] = (f32x4){0.f, 0.f, 0.f, 0.f};
    bf16x8 At[4][2], B0[2][2], B1[2][2]; float raw[8] = {0.f, 0.f, 0.f, 0.f, 0.f, 0.f, 0.f, 0.f};
    const char* cA = (const char*)g.A + (size_t)cur.pm * tstep; const char* cB = (const char*)g.Bt + (size_t)cur.pn * tstep;
    const int rot = (((S.c & 7) * nt) >> 3) & ~1; const size_t rstep = (size_t)rot * kstep;
    PG8_STAGE(PG8_SB(0, 0), cB + rstep, voffB); PG8_STAGE(PG8_SB(0, 1), cB + rstep + hstep, voffB); PG8_STAGE(PG8_SA(0, 0), cA + rstep, voffA); PG8_STAGE(PG8_SA(0, 1), cA + rstep + hstep, voffA);
    if (wr == 1) PG8_BAR;
    PG8_WAIT_V(2); PG8_BAR;
    PG8_STAGE(PG8_SB(1, 0), cB + rstep + kstep, voffB); PG8_STAGE(PG8_SA(1, 0), cA + rstep + kstep, voffA); PG8_STAGE(PG8_SB(1, 1), cB + rstep + hstep + kstep, voffB);
    PG8_WAIT_V(6); PG8_BAR;
    for (;;) {
        const bool has_next = S.next(ui + 1, nxt);
        const char* nA = has_next ? (const char*)g.A + (size_t)nxt.pm * tstep : cA; const char* nB = has_next ? (const char*)g.Bt + (size_t)nxt.pn * tstep : cB;
        const int tmid = (nt >> 1) & ~1;
        for (int t = 0; t < nt; t += 2) {
            if (t == tmid) prefetch_row_sums(E.ss, cur, wr, fr, raw);
            const bool last = (t == nt - 2);
            int k0_ = t + rot; k0_ = k0_ >= nt ? k0_ - nt : k0_; int k2_ = t + 2 + rot; k2_ = k2_ >= nt ? k2_ - nt : k2_;
            const char* a1 = cA + (size_t)(k0_ + 1) * kstep;
            const char* a2 = last ? nA + rstep : cA + (size_t)k2_ * kstep; const char* b2 = last ? nB + rstep : cB + (size_t)k2_ * kstep;
            const char* a3 = a2 + kstep; const char* b3 = b2 + kstep;
            PG8_LDB(B0, 0, 0); PG8_LDB(B1, 0, 1); PG8_SCHED; PG8_LDA(At, 0, 0); PG8_STAGE(PG8_SA(1, 1), a1 + hstep, voffA);
            PG8_WAIT_V(8); PG8_WAIT_L(0); PG8_BAR; PG8_MMA(0, 0, At, B0); PG8_MMA(0, 1, At, B1); PG8_BAR; PG8_SCHED;
            PG8_LDA(At, 0, 1); PG8_STAGE(PG8_SB(0, 0), b2, voffB); PG8_STAGE(PG8_SB(0, 1), b2 + hstep, voffB); PG8_STAGE(PG8_SA(0, 0), a2, voffA);
            PG8_WAIT_V(8); PG8_WAIT_L(0); PG8_BAR; PG8_MMA(1, 0, At, B0); PG8_MMA(1, 1, At, B1); PG8_BAR; PG8_SCHED;
            PG8_LDB(B0, 1, 0); PG8_LDB(B1, 1, 1); PG8_SCHED; PG8_LDA(At, 1, 0); PG8_STAGE(PG8_SA(0, 1), a2 + hstep, voffA);
            PG8_WAIT_V(8); PG8_WAIT_L(0); PG8_BAR; PG8_MMA(0, 0, At, B0); PG8_MMA(0, 1, At, B1); PG8_BAR; PG8_SCHED;
            PG8_LDA(At, 1, 1); PG8_STAGE(PG8_SB(1, 0), b3, voffB); PG8_STAGE(PG8_SB(1, 1), b3 + hstep, voffB); PG8_STAGE(PG8_SA(1, 0), a3, voffA);
            PG8_WAIT_V(8); PG8_WAIT_L(0); PG8_BAR; PG8_MMA(1, 0, At, B0); PG8_MMA(1, 1, At, B1); PG8_BAR; PG8_SCHED;
        }
        if (wr == 0) PG8_BAR;
        E(acc, cur, wr, wc, fr, fq, raw);
        if (!has_next) break;
#pragma unroll
        for (int a = 0; a < 2; ++a)
#pragma unroll
            for (int b = 0; b < 2; ++b)
#pragma unroll
                for (int m = 0; m < 4; ++m)
#pragma unroll
                    for (int n = 0; n < 2; ++n) acc[a][b][m][n] = (f32x4){0.f, 0.f, 0.f, 0.f};
        cur = nxt; cA = nA; cB = nB; ++ui;
        if (wr == 1) PG8_BAR;
    }
    PG8_WAIT_V(0);
    PG8_BAR;
#undef PG8_SA
#undef PG8_SB
#undef PG8_STAGE
#undef PG8_LDA
#undef PG8_LDB
#undef PG8_MMA
#undef PG8_WAIT_V
#undef PG8_WAIT_L
#undef PG8_BAR
#undef PG8_SCHED
}
}

struct P0Item { const float* W; bf16_t* WT; const float* gk; int K, N, mode, item; };
__device__ __forceinline__ void p0_load(const P0Item& d, float (&wv)[32], int lane) {
    const int nblk = d.N / 32, kb = d.item / nblk, nb = d.item % nblk, k0 = 64 * kb, n0 = 32 * nb;
#pragma unroll
    for (int i = 0; i < 32; ++i) wv[i] = d.W[(size_t)(k0 + 2 * i + (lane >> 5)) * d.N + n0 + (lane & 31)];
}
__device__ __forceinline__ void p0_store(const P0Item& d, const float (&wv)[32], LAS float* scr, int lane) {
    const int nblk = d.N / 32, kb = d.item / nblk, nb = d.item % nblk, k0 = 64 * kb, n0 = 32 * nb;
    const int rb = (d.mode == 0) ? n0 : ((n0 >> 7) * 256 + (n0 & 127) + (d.mode == 2 ? 128 : 0));
#pragma unroll
    for (int i = 0; i < 32; ++i) scr[(2 * i + (lane >> 5)) * 33 + (lane & 31)] = wv[i];
    asm volatile("s_waitcnt lgkmcnt(0)" ::: "memory");
    const int c = lane & 7;
    f32x4 ga = (f32x4){1.f, 1.f, 1.f, 1.f}, gb = ga;
    if (d.gk) { ga = *(const f32x4*)(d.gk + k0 + 8 * c); gb = *(const f32x4*)(d.gk + k0 + 8 * c + 4); }
#pragma unroll
    for (int j = 0; j < 4; ++j) { const int n = (lane >> 3) + 8 * j; const LAS float* s = scr + (8 * c) * 33 + n;
        u32x4 o; o.x = cvt_pk_bf16(s[0 * 33] * ga.x, s[1 * 33] * ga.y); o.y = cvt_pk_bf16(s[2 * 33] * ga.z, s[3 * 33] * ga.w); o.z = cvt_pk_bf16(s[4 * 33] * gb.x, s[5 * 33] * gb.y); o.w = cvt_pk_bf16(s[6 * 33] * gb.z, s[7 * 33] * gb.w);
        *(u32x4*)(d.WT + (size_t)(rb + n) * d.K + k0 + 8 * c) = o; }
    asm volatile("s_waitcnt lgkmcnt(0)" ::: "memory");
}

__device__ __forceinline__ void rms_row_process(const f32x4 (&v)[8], float* ss, bf16_t* XN, int m, int lane) {
    float s = 0.f;
    u32x2* o = (u32x2*)(XN + (size_t)m * DM) + lane;
#pragma unroll
    for (int j = 0; j < 8; ++j) { u32x2 w; w.x = cvt_pk_bf16(v[j].x, v[j].y); w.y = cvt_pk_bf16(v[j].z, v[j].w); o[64 * j] = w;
        const f32x4 q = (f32x4){bf_lo(w.x), bf_hi(w.x), bf_lo(w.y), bf_hi(w.y)}; s += (q.x * q.x + q.y * q.y) + (q.z * q.z + q.w * q.w); }
    s = wave_sum(s); if (lane == 0) ss[m] = s;
}
__device__ __forceinline__ void rms_rows(const float* X, float* g, bf16_t* XN, int gw, int NGW, int lane, int M = ::M) {
    f32x4 A[8], B[8];
    int m = gw;
#define RMS_LOAD(R, mm) do { const f32x4* xr_ = (const f32x4*)(X + (size_t)(mm) * DM) + lane; _Pragma("unroll") for (int j = 0; j < 8; ++j) R[j] = xr_[64 * j]; } while (0)
    if (m < M) RMS_LOAD(A, m);
    while (m < M) {
        const int m1 = m + NGW, m2 = m1 + NGW;
        if (m1 < M) RMS_LOAD(B, m1);
        rms_row_process(A, g, XN, m, lane);
        if (m1 >= M) break;
        if (m2 < M) RMS_LOAD(A, m2);
        rms_row_process(B, g, XN, m1, lane);
        m = m2;
    }
#undef RMS_LOAD
}

template <bool IN16> struct RowRegs { u32x2 f[8]; f32x4 h[IN16 ? 1 : 8]; u32x2 h16[IN16 ? 8 : 1]; };
template <bool IN16>
__device__ __forceinline__ void row_load(RowRegs<IN16>& R, const bf16_t* F, const void* Hin, int m, int lane) {
    const u32x2* fp = (const u32x2*)(F + (size_t)m * DM) + lane;
#pragma unroll
    for (int j = 0; j < 8; ++j) { R.f[j] = fp[64 * j];
        if (IN16) R.h16[j] = ((const u32x2*)((const bf16_t*)Hin + (size_t)m * DM) + lane)[64 * j];
        else R.h[j] = ((const f32x4*)((const float*)Hin + (size_t)m * DM) + lane)[64 * j]; }
}
template <bool IN16, bool OUT16>
__device__ __forceinline__ void row_process(const RowRegs<IN16>& R, const float* gpost, float alpha, void* Hout, float* ss, int m, int lane) {
    f32x4 f[8], h[8]; float s = 0.f;
#pragma unroll
    for (int j = 0; j < 8; ++j) { const u32x2 w = R.f[j]; f[j] = (f32x4){bf_lo(w.x), bf_hi(w.x), bf_lo(w.y), bf_hi(w.y)};
        if (IN16) { const u32x2 hw = R.h16[j]; h[j] = (f32x4){bf_lo(hw.x), bf_hi(hw.x), bf_lo(hw.y), bf_hi(hw.y)}; } else h[j] = R.h[j];
        s += (f[j].x * f[j].x + f[j].y * f[j].y) + (f[j].z * f[j].z + f[j].w * f[j].w); }
    const float r1 = alpha / sqrtf(wave_sum(s) * (1.0f / DM) + EPS);
    float s2 = 0.f;
#pragma unroll
    for (int j = 0; j < 8; ++j) { const f32x4 gg = ((const f32x4*)gpost)[lane + 64 * j]; h[j] = h[j] + f[j] * gg * r1;
        if (OUT16) { u32x2 w; w.x = cvt_pk_bf16(h[j].x, h[j].y); w.y = cvt_pk_bf16(h[j].z, h[j].w); ((u32x2*)((bf16_t*)Hout + (size_t)m * DM) + lane)[64 * j] = w;
            h[j] = (f32x4){bf_lo(w.x), bf_hi(w.x), bf_lo(w.y), bf_hi(w.y)}; }
        else ((f32x4*)((float*)Hout + (size_t)m * DM) + lane)[64 * j] = h[j];
        s2 += (h[j].x * h[j].x + h[j].y * h[j].y) + (h[j].z * h[j].z + h[j].w * h[j].w); }
    if (ss) { s2 = wave_sum(s2); if (lane == 0) ss[m] = s2; }
}
template <bool IN16, bool OUT16>
__device__ __forceinline__ void rowpass(const bf16_t* F, const float* gpost, float alpha, const void* Hin, void* Hout, float* ss, int gw, int NGW, int lane, int M = ::M) {
    RowRegs<IN16> A, B;
    int m = gw;
    if (m < M) row_load<IN16>(A, F, Hin, m, lane);
    while (m < M) {
        const int m1 = m + NGW, m2 = m1 + NGW;
        if (m1 < M) row_load<IN16>(B, F, Hin, m1, lane);
        row_process<IN16, OUT16>(A, gpost, alpha, Hout, ss, m, lane);
        if (m1 >= M) break;
        if (m2 < M) row_load<IN16>(A, F, Hin, m2, lane);
        row_process<IN16, OUT16>(B, gpost, alpha, Hout, ss, m1, lane);
        m = m2;
    }
}

constexpr int ATT_NA = BATCH * 16 * 3 * 16, ATT_NB = BATCH * 16 * 16, ATT_NU = ATT_NA + ATT_NB;
struct AttU { int b, qcol, kcol, vcol, dsh, r, blk, wmax, ocol, hidx, br, isA; float slope, sink2; };
__device__ __forceinline__ void att_decode(int u, float sinkv, AttU& a) {
    if (u < ATT_NA) { const int x = u & 15, t = u >> 4, br = t % 3, bh = t / 3, h = bh & 15; a.b = bh >> 4; a.dsh = 2 * br; a.r = x & ((1 << a.dsh) - 1); a.blk = x >> a.dsh;
        a.qcol = h * 64; a.kcol = 1024 + h * 64; a.vcol = 2048 + h * 64; a.wmax = 128; a.slope = __builtin_amdgcn_exp2f(-(float)(2 * h + 1) * 0.25f); a.sink2 = -INFINITY; a.isA = 1; a.br = br; a.ocol = h * 64; a.hidx = h; }
    else { const int v = u - ATT_NA; a.blk = v & 15; const int hq = (v >> 4) & 15; a.b = v >> 8; a.dsh = 0; a.r = 0;
        a.qcol = 3072 + hq * 64; a.kcol = 4096 + (hq >> 3) * 64; a.vcol = 4224 + (hq >> 3) * 64; a.wmax = 127; a.slope = __builtin_amdgcn_exp2f(-(float)(hq + 1) * 0.5f); a.sink2 = __builtin_bit_cast(float, __builtin_amdgcn_readlane(__builtin_bit_cast(int, sinkv), hq)) * LOG2E; a.isA = 0; a.br = 0; a.ocol = hq * 64; a.hidx = hq; }
}
typedef short bf16x4 __attribute__((ext_vector_type(4)));
__device__ __forceinline__ int att_unit_xcd(int p, int xcd, bool xl) {
    if (p >= 2048) return ATT_NU;
    if (p < 1536) { const int gi = p / 48, within = p % 48, bh = xl ? 32 * xcd + gi : gi * 8 + xcd; return (bh * 3 + within / 16) * 16 + (within & 15); }
    const int pb = p - 1536, lin = xl ? 4 * xcd + (pb >> 7) : (pb >> 7) * 8 + xcd, within = pb & 127, b = lin >> 1, hq = (lin & 1) * 8 + (within >> 4);
    return ATT_NA + (b * 16 + hq) * 16 + (within & 15);
}
__device__ __forceinline__ float xrow16_max(float x) {
  auto s = __builtin_amdgcn_permlane16_swap(__float_as_uint(x), __float_as_uint(x), false, false);
  x = fmaxf(__uint_as_float(s[0]), __uint_as_float(s[1]));
  auto t = __builtin_amdgcn_permlane32_swap(__float_as_uint(x), __float_as_uint(x), false, false);
  return fmaxf(__uint_as_float(t[0]), __uint_as_float(t[1]));
}
__device__ __forceinline__ float xrow16_sum(float x) {
  auto s = __builtin_amdgcn_permlane16_swap(__float_as_uint(x), __float_as_uint(x), false, false);
  x = __uint_as_float(s[0]) + __uint_as_float(s[1]);
  auto t = __builtin_amdgcn_permlane32_swap(__float_as_uint(x), __float_as_uint(x), false, false);
  return __uint_as_float(t[0]) + __uint_as_float(t[1]);
}
#define ATT_TR8(v, vb, o0, o1) asm volatile( \
    "ds_read_b64_tr_b16 %0, %8 offset:%12\n\tds_read_b64_tr_b16 %1, %8 offset:%13\n\tds_read_b64_tr_b16 %2, %9 offset:%12\n\tds_read_b64_tr_b16 %3, %9 offset:%13\n\t" \
    "ds_read_b64_tr_b16 %4, %10 offset:%12\n\tds_read_b64_tr_b16 %5, %10 offset:%13\n\tds_read_b64_tr_b16 %6, %11 offset:%12\n\tds_read_b64_tr_b16 %7, %11 offset:%13" \
    : "=&v"(v[0][0]), "=&v"(v[0][1]), "=&v"(v[1][0]), "=&v"(v[1][1]), "=&v"(v[2][0]), "=&v"(v[2][1]), "=&v"(v[3][0]), "=&v"(v[3][1]) \
    : "v"(vb[0]), "v"(vb[1]), "v"(vb[2]), "v"(vb[3]), "i"(o0), "i"(o1) : "memory")
#define ATT_TR4(v, vb, o0) asm volatile( \
    "ds_read_b64_tr_b16 %0, %4 offset:%8\n\tds_read_b64_tr_b16 %1, %5 offset:%8\n\tds_read_b64_tr_b16 %2, %6 offset:%8\n\tds_read_b64_tr_b16 %3, %7 offset:%8" \
    : "=&v"(v[0]), "=&v"(v[1]), "=&v"(v[2]), "=&v"(v[3]) : "v"(vb[0]), "v"(vb[1]), "v"(vb[2]), "v"(vb[3]), "i"(o0) : "memory")
#define ATT_TOUCH8(v) "+v"(v[0][0]), "+v"(v[0][1]), "+v"(v[1][0]), "+v"(v[1][1]), "+v"(v[2][0]), "+v"(v[2][1]), "+v"(v[3][0]), "+v"(v[3][1])
template <bool SKIP>
__device__ __forceinline__ void att_compute(unsigned kb0, unsigned kb1, const unsigned (&vb)[4], bf16x8 q0, bf16x8 q1, float slope2, float sink2, int wmax, int kt_lo, int fr, int fq,
                                            u32x2 (&outO)[4], float& outlse) {
    const float c1 = 0.125f * LOG2E;
    float LBj[4]; int relj[4];
#pragma unroll
    for (int j = 0; j < 4; ++j) { relj[j] = fr - 4 * fq - j; LBj[j] = -slope2 * (float)relj[j]; }
    bf16x8 kf[9][2];
#pragma unroll
    for (int kt = 0; kt < 9; ++kt) { kf[kt][0] = *(const LAS bf16x8*)(size_t)(kb0 + kt * 2048); kf[kt][1] = *(const LAS bf16x8*)(size_t)(kb1 + kt * 2048); }
    f32x4 S[9];
#pragma unroll
    for (int kt = 0; kt < 9; ++kt) S[kt] = __builtin_amdgcn_mfma_f32_16x16x32_bf16(kf[kt][0], q0, (f32x4){0.f, 0.f, 0.f, 0.f}, 0, 0, 0);
#pragma unroll
    for (int kt = 0; kt < 9; ++kt) S[kt] = __builtin_amdgcn_mfma_f32_16x16x32_bf16(kf[kt][1], q1, S[kt], 0, 0, 0);
    bf16x4 vt0[4][2], vt1[4][2], vt2[4][2], vt3[4][2], vt8[4];
    ATT_TR8(vt0, vb, 0 * 2048, 1 * 2048); ATT_TR8(vt1, vb, 2 * 2048, 3 * 2048); ATT_TR8(vt2, vb, 4 * 2048, 5 * 2048); ATT_TR8(vt3, vb, 6 * 2048, 7 * 2048); ATT_TR4(vt8, vb, 8 * 2048);
    float mx = -INFINITY;
#pragma unroll
    for (int kt = 0; kt < 9; ++kt) {
        f32x4 v;
#pragma unroll
        for (int j = 0; j < 4; ++j) { v[j] = S[kt][j] * c1 + LBj[j];
            if (kt == 0) v[j] = (128 + relj[j] <= wmax) ? v[j] : -INFINITY;
            if (kt == 8) v[j] = (relj[j] >= 0) ? v[j] : -INFINITY;
            if (SKIP && kt < 8) v[j] = (kt >= kt_lo) ? v[j] : -INFINITY; }
        S[kt] = v;
        const float tb = slope2 * (float)(16 * kt - 128);
        mx = fmaxf(mx, fmaxf(fmaxf(v[0], v[1]), fmaxf(v[2], v[3])) + tb); }
    mx = xrow16_max(mx);
    mx = fmaxf(mx, sink2);
    float sm = 0.f;
#pragma unroll
    for (int kt = 0; kt < 9; ++kt) {
        const float mk = mx - slope2 * (float)(16 * kt - 128);
#pragma unroll
        for (int j = 0; j < 4; ++j) { const float p = __builtin_amdgcn_exp2f(S[kt][j] - mk); S[kt][j] = p; sm += p; } }
    sm = xrow16_sum(sm);
    sm += __builtin_amdgcn_exp2f(sink2 - mx);
    const float inv = 1.0f / sm;
    bf16x8 P[4];
#pragma unroll
    for (int c = 0; c < 4; ++c) { u32x4 pw; pw.x = cvt_pk_bf16(S[2 * c][0], S[2 * c][1]); pw.y = cvt_pk_bf16(S[2 * c][2], S[2 * c][3]);
        pw.z = cvt_pk_bf16(S[2 * c + 1][0], S[2 * c + 1][1]); pw.w = cvt_pk_bf16(S[2 * c + 1][2], S[2 * c + 1][3]); P[c] = __builtin_bit_cast(bf16x8, pw); }
    u32x2 pw8; pw8.x = cvt_pk_bf16(S[8][0], S[8][1]); pw8.y = cvt_pk_bf16(S[8][2], S[8][3]);
    const bf16x4 P4 = __builtin_bit_cast(bf16x4, pw8);
    asm volatile("s_waitcnt lgkmcnt(0)" : ATT_TOUCH8(vt0), ATT_TOUCH8(vt1) :: "memory");
    asm volatile("" : ATT_TOUCH8(vt2), ATT_TOUCH8(vt3), "+v"(vt8[0]), "+v"(vt8[1]), "+v"(vt8[2]), "+v"(vt8[3]) :: "memory");
    f32x4 O[4];
#pragma unroll
    for (int dt = 0; dt < 4; ++dt) O[dt] = __builtin_amdgcn_mfma_f32_16x16x32_bf16(__builtin_shufflevector(vt0[dt][0], vt0[dt][1], 0, 1, 2, 3, 4, 5, 6, 7), P[0], (f32x4){0.f, 0.f, 0.f, 0.f}, 0, 0, 0);
#pragma unroll
    for (int dt = 0; dt < 4; ++dt) O[dt] = __builtin_amdgcn_mfma_f32_16x16x32_bf16(__builtin_shufflevector(vt1[dt][0], vt1[dt][1], 0, 1, 2, 3, 4, 5, 6, 7), P[1], O[dt], 0, 0, 0);
#pragma unroll
    for (int dt = 0; dt < 4; ++dt) O[dt] = __builtin_amdgcn_mfma_f32_16x16x32_bf16(__builtin_shufflevector(vt2[dt][0], vt2[dt][1], 0, 1, 2, 3, 4, 5, 6, 7), P[2], O[dt], 0, 0, 0);
#pragma unroll
    for (int dt = 0; dt < 4; ++dt) O[dt] = __builtin_amdgcn_mfma_f32_16x16x32_bf16(__builtin_shufflevector(vt3[dt][0], vt3[dt][1], 0, 1, 2, 3, 4, 5, 6, 7), P[3], O[dt], 0, 0, 0);
#pragma unroll
    for (int dt = 0; dt < 4; ++dt) O[dt] = __builtin_amdgcn_mfma_f32_16x16x16bf16_1k(vt8[dt], P4, O[dt], 0, 0, 0);
#pragma unroll
    for (int dt = 0; dt < 4; ++dt) { const f32x4 o = O[dt] * inv; outO[dt].x = cvt_pk_bf16(o[0], o[1]); outO[dt].y = cvt_pk_bf16(o[2], o[3]); }
    outlse = (mx + __log2f(sm)) * LN2;
}

constexpr int ATT_BUF = 65536;
__device__ __forceinline__ void attn_phase(LAS unsigned char* lds, const bf16_t* Z, bf16_t* OAp, float* LSEp, bf16_t* OBp, const float* sinks, int G, int vc, bool xl) {
    const int tid = threadIdx.x, lane = tid & 63, fr = lane & 15, fq = lane >> 4;
    const int wv = __builtin_amdgcn_readfirstlane(tid >> 6);
    const int drow = lane >> 3, dchunk = (lane & 7) ^ drow;
    const unsigned koff0 = (unsigned)((16 * wv + fr) * 128 + ((fq ^ (fr & 7) ^ (fr >> 3)) * 16)), koff1 = koff0 ^ 64u;
    const int vq = (lane & 15) >> 2, vp = lane & 3, vrow = 4 * fq + vq;
    unsigned voff[4];
#pragma unroll
    for (int dt = 0; dt < 4; ++dt) voff[dt] = (unsigned)((16 * wv + vrow) * 128 + (((2 * dt + (vp >> 1)) ^ (vrow & 7) ^ (vrow >> 3)) * 16) + 8 * (vp & 1));
    bf16x8 Qn[2];
    AttU cu;
    const float sinkv = sinks[lane & 15];
#define ATT_ISSUE(a, bufb) do { const size_t rowbase_ = (size_t)(a).b * SEQ; \
        _Pragma("unroll") for (int ks = 0; ks < 2; ++ks) \
            Qn[ks] = *(const bf16x8*)(Z + (rowbase_ + ((((a).blk * 128 + 16 * wv + fr) << (a).dsh) + (a).r)) * NQKV + (a).qcol + ks * 32 + fq * 8); \
        _Pragma("unroll") for (int i = 0; i < 4; ++i) { const int rg = wv * 4 + i; int fj = (a).blk * 128 - 128 + 8 * rg + drow; fj = fj < 0 ? 0 : fj; \
            const bf16_t* gp = Z + (rowbase_ + (fj << (a).dsh) + (a).r) * NQKV + (dchunk ^ (i & 1)) * 8; \
            __builtin_amdgcn_global_load_lds((const unsigned*)(gp + (a).kcol), (LAS unsigned*)((bufb) + rg * 1024), 16, 0, 0); \
            __builtin_amdgcn_global_load_lds((const unsigned*)(gp + (a).vcol), (LAS unsigned*)((bufb) + 32768 + rg * 1024), 16, 0, 0); } } while (0)
    const bool xmap = (G == 256); const int xcd = vc & 7, cix = vc >> 3;
#define ATT_UNIT(it_) (xmap ? att_unit_xcd((it_) * 32 + cix, xcd, xl) : ((long)(it_) * G + vc < ATT_NU ? (int)((it_) * G + vc) : ATT_NU))
    int u = ATT_UNIT(0);
    if (u < ATT_NU) { att_decode(u, sinkv, cu); ATT_ISSUE(cu, lds); }
    __syncthreads();
    u32x2 pendO[4]; bf16_t* pendp = nullptr; float* pendl = nullptr; float pendlse = 0.f;
    for (int it = 0; u < ATT_NU; ++it) {
        const int unext = ATT_UNIT(it + 1);
        LAS unsigned char* Kb = lds + (it & 1) * ATT_BUF; LAS unsigned char* Vb = Kb + 32768;
        const bf16x8 q0 = Qn[0], q1 = Qn[1];
        AttU nu = cu;
        if (unext < ATT_NU) { att_decode(unext, sinkv, nu); ATT_ISSUE(nu, lds + ((it + 1) & 1) * ATT_BUF); }
        if (pendp) {
#pragma unroll
            for (int dt = 0; dt < 4; ++dt) *(u32x2*)(pendp + dt * 16) = pendO[dt];
            if (pendl) *pendl = pendlse; }
        { const int t = ((cu.blk * 128 + 16 * wv + fr) << cu.dsh) + cu.r; const size_t row = (size_t)cu.b * SEQ + t;
          bf16_t* Op = cu.isA ? OAp + (size_t)cu.br * M * AW : OBp;
          pendp = Op + row * AW + cu.ocol + fq * 4;
          pendl = (cu.isA && fq == 0) ? LSEp + ((size_t)cu.br * M + row) * 16 + cu.hidx : nullptr;
          const float slope2 = cu.slope * (float)(1 << cu.dsh) * LOG2E;
          const unsigned kb0 = (unsigned)(size_t)Kb + koff0, kb1 = (unsigned)(size_t)Kb + koff1;
          unsigned vb[4];
#pragma unroll
          for (int dt = 0; dt < 4; ++dt) vb[dt] = (unsigned)(size_t)Vb + voff[dt];
          if (cu.blk != 0) att_compute<false>(kb0, kb1, vb, q0, q1, slope2, cu.sink2, cu.wmax, 0, fr, fq, pendO, pendlse);
          else att_compute<true>(kb0, kb1, vb, q0, q1, slope2, cu.sink2, cu.wmax, 8 - wv, fr, fq, pendO, pendlse); }
        __syncthreads();
        cu = nu; u = unext;
    }
    if (pendp) {
#pragma unroll
        for (int dt = 0; dt < 4; ++dt) *(u32x2*)(pendp + dt * 16) = pendO[dt];
        if (pendl) *pendl = pendlse; }
    __syncthreads();
#undef ATT_ISSUE
#undef ATT_UNIT
}

struct CombRegs { u32x4 a[3][2]; u32x4 b[2]; float l[3]; };
__device__ __forceinline__ void comb_load(CombRegs& R, const bf16_t* OA, const float* LSE, const bf16_t* OB, int m, int lane) {
    const int h = lane >> 2;
#pragma unroll
    for (int br = 0; br < 3; ++br) { R.l[br] = LSE[((size_t)br * M + m) * 16 + h];
#pragma unroll
        for (int hf = 0; hf < 2; ++hf) R.a[br][hf] = *(const u32x4*)(OA + ((size_t)br * M + m) * AW + lane * 16 + hf * 8); }
#pragma unroll
    for (int hf = 0; hf < 2; ++hf) R.b[hf] = *(const u32x4*)(OB + (size_t)m * AW + lane * 16 + hf * 8);
}
__device__ __forceinline__ void comb_process(const CombRegs& R, const float* gA, const float* gB, bf16_t* XN, int m, int lane) {
    const float mx = fmaxf(R.l[0], fmaxf(R.l[1], R.l[2])); float w0 = __expf(R.l[0] - mx), w1 = __expf(R.l[1] - mx), w2 = __expf(R.l[2] - mx); const float ws = 1.0f / (w0 + w1 + w2); w0 *= ws; w1 *= ws; w2 *= ws;
    float oa[16], ob[16]; float sa = 0.f, sb = 0.f;
#pragma unroll
    for (int hf = 0; hf < 2; ++hf) {
        const u32x4 a0 = R.a[0][hf], a1 = R.a[1][hf], a2 = R.a[2][hf], bq = R.b[hf];
#pragma unroll
        for (int e = 0; e < 4; ++e) {
            oa[hf * 8 + 2 * e] = w0 * bf_lo(a0[e]) + w1 * bf_lo(a1[e]) + w2 * bf_lo(a2[e]); oa[hf * 8 + 2 * e + 1] = w0 * bf_hi(a0[e]) + w1 * bf_hi(a1[e]) + w2 * bf_hi(a2[e]);
            ob[hf * 8 + 2 * e] = bf_lo(bq[e]); ob[hf * 8 + 2 * e + 1] = bf_hi(bq[e]); }
    }
#pragma unroll
    for (int e = 0; e < 16; ++e) { sa += oa[e] * oa[e]; sb += ob[e] * ob[e]; }
    const float ra = 1.0f / sqrtf(wave_sum(sa) * (1.0f / AW) + EPS), rb = 1.0f / sqrtf(wave_sum(sb) * (1.0f / AW) + EPS);
#pragma unroll
    for (int hf = 0; hf < 2; ++hf) {
        const f32x4 ga0 = *(const f32x4*)(gA + lane * 16 + hf * 8), ga1 = *(const f32x4*)(gA + lane * 16 + hf * 8 + 4), gb0 = *(const f32x4*)(gB + lane * 16 + hf * 8), gb1 = *(const f32x4*)(gB + lane * 16 + hf * 8 + 4);
        u32x4 wa, wb;
        wa.x = cvt_pk_bf16(oa[hf * 8 + 0] * ra * ga0.x, oa[hf * 8 + 1] * ra * ga0.y); wa.y = cvt_pk_bf16(oa[hf * 8 + 2] * ra * ga0.z, oa[hf * 8 + 3] * ra * ga0.w);
        wa.z = cvt_pk_bf16(oa[hf * 8 + 4] * ra * ga1.x, oa[hf * 8 + 5] * ra * ga1.y); wa.w = cvt_pk_bf16(oa[hf * 8 + 6] * ra * ga1.z, oa[hf * 8 + 7] * ra * ga1.w);
        wb.x = cvt_pk_bf16(ob[hf * 8 + 0] * rb * gb0.x, ob[hf * 8 + 1] * rb * gb0.y); wb.y = cvt_pk_bf16(ob[hf * 8 + 2] * rb * gb0.z, ob[hf * 8 + 3] * rb * gb0.w);
        wb.z = cvt_pk_bf16(ob[hf * 8 + 4] * rb * gb1.x, ob[hf * 8 + 5] * rb * gb1.y); wb.w = cvt_pk_bf16(ob[hf * 8 + 6] * rb * gb1.z, ob[hf * 8 + 7] * rb * gb1.w);
        *(u32x4*)(XN + (size_t)m * DM + lane * 16 + hf * 8) = wa; *(u32x4*)(XN + (size_t)m * DM + AW + lane * 16 + hf * 8) = wb; }
}
__device__ __forceinline__ void combine_rows(const bf16_t* OA, const float* LSE, const bf16_t* OB, const float* gA, const float* gB, bf16_t* XN, int gw, int NGW, int lane, int M = ::M) {
    CombRegs A, B;
    int m = gw;
    if (m < M) comb_load(A, OA, LSE, OB, m, lane);
    while (m < M) {
        const int m1 = m + NGW, m2 = m1 + NGW;
        if (m1 < M) comb_load(B, OA, LSE, OB, m1, lane);
        comb_process(A, gA, gB, XN, m, lane);
        if (m1 >= M) break;
        if (m2 < M) comb_load(A, OA, LSE, OB, m2, lane);
        comb_process(B, gA, gB, XN, m1, lane);
        m = m2;
    }
}

#define XB_TMO      128
#define XB_XCNT(j)  (256  + 64 * (j))
#define XB_XSUB(j)  (1280 + 64 * (j))
#define XB_XGEN(j)  (2304 + 64 * (j))
#define XB_TOP      3328
#define XB_TOPGEN   3392
#define XCD_BAR_WORDS 3456
#define XB_SPIN_CAP (1u << 18)
__device__ __forceinline__ unsigned xb_ld(unsigned* p)              { return __hip_atomic_load(p, __ATOMIC_RELAXED, __HIP_MEMORY_SCOPE_AGENT); }
__device__ __forceinline__ unsigned xb_add(unsigned* p, unsigned v) { return __hip_atomic_fetch_add(p, v, __ATOMIC_RELAXED, __HIP_MEMORY_SCOPE_AGENT); }
__device__ __forceinline__ unsigned xb_xcc_id() { return (unsigned)__builtin_amdgcn_s_getreg((3 << 11) | 20) & 0xFu; }
#define XB_SPIN(cond, bar) do { unsigned _sp = 0; while (cond) { __builtin_amdgcn_s_sleep(1); \
    if ((++_sp & 255u) == 0u) { if (xb_ld(&(bar)[XB_TMO])) break; if (_sp > XB_SPIN_CAP) { atomicAdd(&(bar)[XB_TMO], 1u); break; } } } } while (0)
struct XcdBarrier { unsigned* bar; unsigned x; volatile LAS unsigned* st; };
__device__ __forceinline__ XcdBarrier xcd_barrier_post(unsigned* bar, volatile LAS unsigned* st) {
    XcdBarrier b; b.bar = bar; b.x = xb_xcc_id(); b.st = st;
    if (threadIdx.x == 0) (void)xb_add(&bar[XB_XCNT(b.x)], 1u);
    return b;
}
__device__ __forceinline__ void xcd_barrier_complete(unsigned* bar, unsigned x, unsigned& nloc, unsigned& nx) {
    const unsigned G = gridDim.x * gridDim.y * gridDim.z;
    unsigned sum, cnt, mine, sp = 0u;
    for (;;) {
        sum = 0u; cnt = 0u; mine = 0u;
#pragma unroll
        for (unsigned j = 0; j < 16; ++j) { const unsigned c = xb_ld(&bar[XB_XCNT(j)]); sum += c; cnt += (c > 0u) ? 1u : 0u; mine = (j == x) ? c : mine; }
        if (sum == G) break;
        __builtin_amdgcn_s_sleep(1);
        if ((++sp & 255u) == 0u) { if (xb_ld(&bar[XB_TMO])) break; if (sp > XB_SPIN_CAP) { atomicAdd(&bar[XB_TMO], 1u); break; } }
    }
    nloc = mine > 0u ? mine : 1u; nx = cnt > 0u ? cnt : 1u;
}
__device__ __forceinline__ void xcd_barrier(const XcdBarrier& b) {
    asm volatile("s_waitcnt vmcnt(0)" ::: "memory");
    __syncthreads();
    if (threadIdx.x == 0) {
        unsigned* bar = b.bar;
        __builtin_amdgcn_s_waitcnt(0);
        unsigned nloc = b.st[0], nx = b.st[1];
        if (nloc == 0u) { xcd_barrier_complete(bar, b.x, nloc, nx); b.st[0] = nloc; b.st[1] = nx; }
        const unsigned old = xb_add(&bar[XB_XSUB(b.x)], 1u);
        const unsigned gen = old / nloc;
        if (old + 1u == (gen + 1u) * nloc) {
            __builtin_amdgcn_fence(__ATOMIC_RELEASE, "agent");
            asm volatile("s_waitcnt vmcnt(0)" ::: "memory");
            const unsigned og = xb_add(&bar[XB_TOP], 1u);
            const unsigned tg = og / nx;
            if (og + 1u == (tg + 1u) * nx) xb_add(&bar[XB_TOPGEN], 1u);
            else XB_SPIN(xb_ld(&bar[XB_TOPGEN]) == tg, bar);
            __builtin_amdgcn_fence(__ATOMIC_ACQUIRE, "agent");
            xb_add(&bar[XB_XGEN(b.x)], 1u);
            asm volatile("s_waitcnt vmcnt(0)" ::: "memory");
        } else {
            XB_SPIN(xb_ld(&bar[XB_XGEN(b.x)]) == gen, bar);
            __builtin_amdgcn_fence(__ATOMIC_ACQUIRE, "agent");
            asm volatile("s_waitcnt vmcnt(0)" ::: "memory");
        }
    }
    __syncthreads();
}

#define XL_SUB(j)  (4096 + 64 * (j))
#define XL_GEN(j)  (4608 + 64 * (j))
#define XL_CNT(j)  (5120 + 64 * (j))
__device__ __forceinline__ void xl_barrier(unsigned* bar, unsigned x, unsigned nloc) {
    asm volatile("s_waitcnt vmcnt(0)" ::: "memory");
    __syncthreads();
    if (threadIdx.x == 0) {
        __builtin_amdgcn_s_waitcnt(0);
        const unsigned old = xb_add(&bar[XL_SUB(x)], 1u);
        const unsigned gen = old / nloc;
        if (old + 1u == (gen + 1u) * nloc) xb_add(&bar[XL_GEN(x)], 1u);
        else XB_SPIN(xb_ld(&bar[XL_GEN(x)]) == gen, bar);
        __builtin_amdgcn_fence(__ATOMIC_ACQUIRE, "agent");
        asm volatile("s_waitcnt vmcnt(0)" ::: "memory");
    }
    __syncthreads();
}

enum { I_X = 0, I_P, I_G1PRE, I_W1G, I_W1U, I_W1D, I_G1POST, I_GMIXPRE, I_WQKV, I_BQKV, I_SINKS, I_GOA, I_GOB, I_WO, I_BO, I_GMIXPOST, I_G2PRE, I_W2G, I_W2U, I_W2D, I_G2POST, I_GPLEPRE, I_WPG, I_WPP, I_GPLEPOST, N_IN };
struct Args { const float* in[N_IN]; float* out; unsigned char* ws; int ph_lo, ph_hi; };
constexpr int N_PHASES = 14;

__global__ void __launch_bounds__(512, 2) mk_fwd(Args args) {
    extern __shared__ __attribute__((aligned(16))) unsigned char lds_raw[];
    LAS unsigned char* lds = (LAS unsigned char*)lds_raw;
    cg::grid_group grid = cg::this_grid();
    const int tid = threadIdx.x, lane = tid & 63, wave = __builtin_amdgcn_readfirstlane(tid >> 6);
    const int G = gridDim.x, gw = blockIdx.x * 8 + wave, NGW = G * 8;
    unsigned char* ws = args.ws;
#define W1GU ((bf16_t*)(ws + WS_W1GU))
#define W1D ((bf16_t*)(ws + WS_W1D))
#define W2GU ((bf16_t*)(ws + WS_W2GU))
#define W2D ((bf16_t*)(ws + WS_W2D))
#define WQKV ((bf16_t*)(ws + WS_WQKV))
#define WO ((bf16_t*)(ws + WS_WO))
#define WG ((bf16_t*)(ws + WS_WG))
#define WP ((bf16_t*)(ws + WS_WP))
#define XN ((bf16_t*)(ws + WS_XN))
#define ACT ((bf16_t*)(ws + WS_ACT))
#define Zb ((bf16_t*)(ws + WS_Z))
#define OB ((bf16_t*)(ws + WS_OB))
#define Fb ((bf16_t*)(ws + WS_F))
#define OA ((bf16_t*)(ws + WS_OA))
#define LSE ((float*)(ws + WS_LSE))
#define PB ((bf16_t*)(ws + WS_PB))
#define Eb ((bf16_t*)(ws + WS_E))
#define OUT (args.out)
#define SS(k) ((float*)(ws + 65536 + (size_t)(k) * M * 4))
#define H16A ((bf16_t*)args.out)
#define H16B ((bf16_t*)(ws + WS_XN))
    const int lo = args.ph_lo, hi = args.ph_hi;
#define IN(k) (lo <= (k) && (k) < hi)
#define REP(k) for (int rep_ = 0; rep_ < 1 + ((DUP_MASK >> (k)) & 1); ++rep_)
#if MK_N_LAUNCHES == 1
    volatile LAS unsigned* MISC = (volatile LAS unsigned*)(lds + LDS_BYTES - 256);
    if (tid < 64) MISC[tid] = 0u;
    __syncthreads();
    const XcdBarrier xbar = xcd_barrier_post((unsigned*)ws, MISC + 8);
    if (tid == 0) MISC[16] = xb_add((unsigned*)ws + XL_CNT(xbar.x < 8u ? xbar.x : 8u), 1u);
    __syncthreads();
    const unsigned xrank = (unsigned)__builtin_amdgcn_readfirstlane((int)MISC[16]);
    bool xl = false; int vc = (int)blockIdx.x;
#define SEAM(k) do { if (IN(k) && IN((k) + 1)) { if ((k) == 0) grid.sync(); else if (xl && (k) != 3 && (k) != 6 && (k) != 12) xl_barrier((unsigned*)ws, xbar.x, 32u); else xcd_barrier(xbar); } } while (0)
#else
#define SEAM(k) do { } while (0)
#endif

    if (IN(0)) REP(0) {
        LAS float* scr = (LAS float*)(lds + wave * 16384);
        constexpr int I_GU = (DM / 64) * (FF / 32), I_D = (FF / 64) * (DM / 32), I_QKV = (DM / 64) * (NQKV / 32), I_SQ = (DM / 64) * (DM / 32), I_PP = (PLE / 64) * (DM / 32);
        constexpr int NITEMS = 4 * I_GU + 2 * I_D + I_QKV + 2 * I_SQ + I_PP;
#define P0_DECODE(it_, d_) do { int r = (it_); \
            if (r < I_GU) { d_ = P0Item{args.in[I_W1G], W1GU, args.in[I_G1PRE], DM, FF, 1, r}; break; } r -= I_GU; \
            if (r < I_GU) { d_ = P0Item{args.in[I_W1U], W1GU, args.in[I_G1PRE], DM, FF, 2, r}; break; } r -= I_GU; \
            if (r < I_GU) { d_ = P0Item{args.in[I_W2G], W2GU, args.in[I_G2PRE], DM, FF, 1, r}; break; } r -= I_GU; \
            if (r < I_GU) { d_ = P0Item{args.in[I_W2U], W2GU, args.in[I_G2PRE], DM, FF, 2, r}; break; } r -= I_GU; \
            if (r < I_D) { d_ = P0Item{args.in[I_W1D], W1D, nullptr, FF, DM, 0, r}; break; } r -= I_D; \
            if (r < I_D) { d_ = P0Item{args.in[I_W2D], W2D, nullptr, FF, DM, 0, r}; break; } r -= I_D; \
            if (r < I_QKV) { d_ = P0Item{args.in[I_WQKV], WQKV, args.in[I_GMIXPRE], DM, NQKV, 0, r}; break; } r -= I_QKV; \
            if (r < I_SQ) { d_ = P0Item{args.in[I_WO], WO, nullptr, DM, DM, 0, r}; break; } r -= I_SQ; \
            if (r < I_SQ) { d_ = P0Item{args.in[I_WPG], WG, args.in[I_GPLEPRE], DM, DM, 0, r}; break; } r -= I_SQ; \
            d_ = P0Item{args.in[I_WPP], WP, nullptr, PLE, DM, 0, r}; } while (0)
        { float wa[32], wb[32]; P0Item da, db; int it = gw;
          if (it < NITEMS) { P0_DECODE(it, da); p0_load(da, wa, lane); }
          while (it < NITEMS) {
              const int i1 = it + NGW, i2 = i1 + NGW;
              if (i1 < NITEMS) { P0_DECODE(i1, db); p0_load(db, wb, lane); }
              p0_store(da, wa, scr, lane);
              if (i1 >= NITEMS) break;
              if (i2 < NITEMS) { P0_DECODE(i2, da); p0_load(da, wa, lane); }
              p0_store(db, wb, scr, lane);
              it = i2;
          } }
#undef P0_DECODE
        rms_rows(args.in[I_X], SS(0), XN, gw, NGW, lane);
        const float* P = args.in[I_P];
        for (size_t i = (size_t)blockIdx.x * 512 + tid; i < (size_t)M * PLE / 8; i += (size_t)G * 512) {
            const f32x4 a = ((const f32x4*)P)[2 * i], b = ((const f32x4*)P)[2 * i + 1];
            u32x4 w; w.x = cvt_pk_bf16(a.x, a.y); w.y = cvt_pk_bf16(a.z, a.w); w.z = cvt_pk_bf16(b.x, b.y); w.w = cvt_pk_bf16(b.z, b.w);
            ((u32x4*)PB)[i] = w; }
        __syncthreads();
    }
    SEAM(0);
#if MK_N_LAUNCHES == 1
    if (IN(0) && IN(1) && G == 256) { bool ok = true;
#pragma unroll
        for (int j = 0; j < 8; ++j) ok = ok && (xb_ld((unsigned*)ws + XL_CNT(j)) == 32u);
        if (ok) { xl = true; vc = (int)(xbar.x + 8u * xrank); } }
#endif
    const int rw0 = xl ? 4096 * (vc & 7) + (vc >> 3) * 8 + wave : gw, rwS = xl ? 256 : NGW, rwE = xl ? 4096 * (vc & 7) + 4096 : M;
    if (IN(1)) REP(1) {
        { pg8::Gemm g{XN, W1GU, M, 2 * FF, DM}; pg8::StaticOrder S; S.init(M, 2 * FF, G, vc); pg8::EpiSwiGLU E{ACT, FF, SS(0)}; pg8::gemm_phase(lds, g, S, E); }
        { pg8::Gemm g{PB, WP, M, DM, PLE}; pg8::StaticOrder S; S.init(M, DM, G, vc); pg8::EpiBf16 E{Eb, DM, nullptr, nullptr}; pg8::gemm_phase(lds, g, S, E); }
    }
    SEAM(1);
    if (IN(2)) REP(2) { pg8::Gemm g{ACT, W1D, M, DM, FF}; pg8::StaticOrder S; S.init(M, DM, G, vc); pg8::EpiBf16 E{Fb, DM, nullptr, nullptr}; pg8::gemm_phase(lds, g, S, E); }
    SEAM(2);
    if (IN(3)) REP(3) rowpass<false, true>(Fb, args.in[I_G1POST], 0.5f, args.in[I_X], H16A, SS(1), rw0, rwS, lane, rwE);
    SEAM(3);
    if (IN(4)) REP(4) { pg8::Gemm g{H16A, WQKV, M, NQKV, DM}; pg8::StaticOrder S; S.init(M, NQKV, G, vc); pg8::EpiBf16 E{Zb, NQKV, args.in[I_BQKV], SS(1)}; pg8::gemm_phase(lds, g, S, E); }
    SEAM(4);
    if (IN(5)) REP(5) attn_phase(lds, Zb, OA, LSE, OB, args.in[I_SINKS], G, vc, xl);
    SEAM(5);
    if (IN(6)) REP(6) combine_rows(OA, LSE, OB, args.in[I_GOA], args.in[I_GOB], XN, rw0, rwS, lane, rwE);
    SEAM(6);
    if (IN(7)) REP(7) { pg8::Gemm g{XN, WO, M, DM, DM}; pg8::StaticOrder S; S.init(M, DM, G, vc); pg8::EpiBf16 E{Fb, DM, args.in[I_BO], nullptr}; pg8::gemm_phase(lds, g, S, E); }
    SEAM(7);
    if (IN(8)) REP(8) rowpass<true, true>(Fb, args.in[I_GMIXPOST], 1.0f, H16A, H16A, SS(2), rw0, rwS, lane, rwE);
    SEAM(8);
    if (IN(9)) REP(9) { pg8::Gemm g{H16A, W2GU, M, 2 * FF, DM}; pg8::StaticOrder S; S.init(M, 2 * FF, G, vc); pg8::EpiSwiGLU E{ACT, FF, SS(2)}; pg8::gemm_phase(lds, g, S, E); }
    SEAM(9);
    if (IN(10)) REP(10) { pg8::Gemm g{ACT, W2D, M, DM, FF}; pg8::StaticOrder S; S.init(M, DM, G, vc); pg8::EpiBf16 E{Fb, DM, nullptr, nullptr}; pg8::gemm_phase(lds, g, S, E); }
    SEAM(10);
    if (IN(11)) REP(11) rowpass<true, true>(Fb, args.in[I_G2POST], 0.5f, H16A, H16B, SS(3), rw0, rwS, lane, rwE);
    SEAM(11);
    if (IN(12)) REP(12) { pg8::Gemm g{H16B, WG, M, DM, DM}; pg8::StaticOrder S; S.init(M, DM, G, vc); pg8::EpiSigMul E{Fb, Eb, DM, SS(3)}; pg8::gemm_phase(lds, g, S, E); }
    SEAM(12);
    if (IN(13)) REP(13) rowpass<true, false>(Fb, args.in[I_GPLEPOST], 1.0f, H16B, OUT, nullptr, rw0, rwS, lane, rwE);
#undef IN
#undef REP
#undef SEAM
}

extern "C" void kernel_launch(void* const* d_in, const int* in_sizes, int n_in, void* d_out, int out_size, void* d_ws, size_t ws_size, hipStream_t stream) {
    static int grid = 0;
    if (grid == 0) {
        if (n_in != N_IN || in_sizes[0] != M * DM || out_size != M * DM || ws_size < WS_END) { fprintf(stderr, "kernel_launch: unexpected problem: n_in %d in0 %d out %d ws %zu (need %zu)\n", n_in, n_in > 0 ? in_sizes[0] : -1, out_size, ws_size, (size_t)WS_END); grid = -1; return; }
        int dev = 0, cus = 0, per_cu = 0;
        if (hipGetDevice(&dev) != hipSuccess || hipDeviceGetAttribute(&cus, hipDeviceAttributeMultiprocessorCount, dev) != hipSuccess) { grid = -1; return; }
        if (hipFuncSetAttribute((const void*)mk_fwd, hipFuncAttributeMaxDynamicSharedMemorySize, LDS_BYTES) != hipSuccess) { fprintf(stderr, "kernel_launch: hipFuncSetAttribute failed\n"); grid = -1; return; }
        if (hipOccupancyMaxActiveBlocksPerMultiprocessor(&per_cu, (const void*)mk_fwd, 512, LDS_BYTES) != hipSuccess || per_cu < 1) { fprintf(stderr, "kernel_launch: occupancy query says %d\n", per_cu); per_cu = 1; }
        (void)hipGetLastError();
        grid = cus * per_cu;
    }
    if (grid < 0) return;
    Args a{};
    for (int i = 0; i < N_IN; ++i) a.in[i] = (const float*)d_in[i];
    a.out = (float*)d_out; a.ws = (unsigned char*)d_ws;
#if MK_N_LAUNCHES == 1
    if (hipMemsetAsync(d_ws, 0, 32768, stream) != hipSuccess) { fprintf(stderr, "kernel_launch: memset failed\n"); return; }
    a.ph_lo = 0; a.ph_hi = N_PHASES;
    void* kargs[] = {&a};
    hipError_t e = hipLaunchCooperativeKernel((const void*)mk_fwd, dim3(grid), dim3(512), kargs, LDS_BYTES, stream);
    if (e != hipSuccess) fprintf(stderr, "kernel_launch: cooperative launch failed: %s (grid %d)\n", hipGetErrorString(e), grid);
#else
    for (int ph = 0; ph < N_PHASES; ++ph) { a.ph_lo = ph; a.ph_hi = ph + 1; hipLaunchKernelGGL(mk_fwd, dim3(grid), dim3(512), LDS_BYTES, stream, a); }
#endif
}
```

```cpp
#include <hip/hip_runtime.h>
#include <hip/hip_cooperative_groups.h>
#include <cstdio>
#include <cstdint>
namespace cg = cooperative_groups;

#ifndef MK_N_LAUNCHES
#define MK_N_LAUNCHES 1
#endif

#ifndef DUP_MASK
#define DUP_MASK 0
#endif
#define LAS __attribute__((address_space(3)))
typedef unsigned short bf16_t;
typedef short bf16x8 __attribute__((ext_vector_type(8)));
typedef float f32x4 __attribute__((ext_vector_type(4)));
typedef float f32x2 __attribute__((ext_vector_type(2)));
typedef unsigned u32x4 __attribute__((ext_vector_type(4)));
typedef unsigned u32x2 __attribute__((ext_vector_type(2)));

constexpr int DM = 2048, BATCH = 16, SEQ = 2048, M = BATCH * SEQ;
constexpr int FF = 5632, NQKV = 4352, PLE = 256, AW = 1024;
constexpr float EPS = 1e-6f;
constexpr float LOG2E = 1.4426950408889634f, LN2 = 0.6931471805599453f;

constexpr size_t MiB = 1u << 20;
constexpr size_t WS_W1GU = 1 * MiB;
constexpr size_t WS_W1D  = WS_W1GU + 44 * MiB;
constexpr size_t WS_W2GU = WS_W1D + 22 * MiB;
constexpr size_t WS_W2D  = WS_W2GU + 44 * MiB;
constexpr size_t WS_WQKV = WS_W2D + 22 * MiB;
constexpr size_t WS_WO   = WS_WQKV + 17 * MiB;
constexpr size_t WS_WG   = WS_WO + 8 * MiB;
constexpr size_t WS_WP   = WS_WG + 8 * MiB;
constexpr size_t WS_XN   = WS_WP + 1 * MiB;
constexpr size_t WS_ACT  = WS_XN + 128 * MiB;
constexpr size_t WS_Z    = WS_ACT;
constexpr size_t WS_OB   = WS_ACT + 272 * MiB;
constexpr size_t WS_F    = WS_ACT + 352 * MiB;
constexpr size_t WS_OA   = WS_F;
constexpr size_t WS_LSE  = WS_F + 192 * MiB;
constexpr size_t WS_PB   = WS_LSE + 6 * MiB;
constexpr size_t WS_E    = WS_PB + 16 * MiB;
constexpr size_t WS_END  = WS_E + 128 * MiB;
static_assert(WS_END <= 1024 * MiB, "workspace map");

constexpr int RING_BYTES = 131072;
constexpr int LDS_BYTES = 147456;

__device__ __forceinline__ unsigned cvt_pk_bf16(float lo, float hi) { unsigned r; asm volatile("v_cvt_pk_bf16_f32 %0, %1, %2" : "=v"(r) : "v"(lo), "v"(hi)); return r; }
__device__ __forceinline__ float bf_lo(unsigned w) { return __builtin_bit_cast(float, w << 16); }
__device__ __forceinline__ float bf_hi(unsigned w) { return __builtin_bit_cast(float, w & 0xffff0000u); }
template <int CTRL> __device__ __forceinline__ float dpp_mov(float x) { return __builtin_bit_cast(float, __builtin_amdgcn_mov_dpp(__builtin_bit_cast(int, x), CTRL, 0xf, 0xf, true)); }
__device__ __forceinline__ float wave_sum(float v) {
    v += dpp_mov<0xB1>(v); v += dpp_mov<0x4E>(v); v += dpp_mov<0x141>(v); v += dpp_mov<0x140>(v);
    auto s = __builtin_amdgcn_permlane16_swap(__float_as_uint(v), __float_as_uint(v), false, false);
    v = __uint_as_float(s[0]) + __uint_as_float(s[1]);
    auto t = __builtin_amdgcn_permlane32_swap(__float_as_uint(v), __float_as_uint(v), false, false);
    return __uint_as_float(t[0]) + __uint_as_float(t[1]);
}

namespace pg8 {
constexpr int BM = 256, BK = 64, HALF = 128, HTB = HALF * BK * 2, STAGE_BYTES = 8 * HTB, NXCD = 8, WGM = 4;
__host__ __device__ __forceinline__ int lds_byte(int r, int c) { const int st = (r >> 4) * 2 + (c >> 5), rr = r & 15, cc = c & 31, ob = rr * 64 + cc * 2; return st * 1024 + (ob ^ (((ob >> 9) & 1) << 5)); }
__host__ __device__ __forceinline__ void stage_rc(int b, int& R, int& C) { const int st = b / 1024, sb = b % 1024, swz = sb ^ (((sb >> 9) & 1) << 5); R = (st >> 1) * 16 + swz / 64; C = (st & 1) * 32 + (swz % 64) / 2; }
__host__ __device__ __forceinline__ int perm32(int rho) { const int n = rho >> 4, i = rho & 15; return 8 * (i >> 2) + 4 * n + (i & 3); }

struct Unit { int pm, pn; };
struct Gemm { const bf16_t* A; const bf16_t* Bt; int M, N, K; };

struct StaticOrder {
    int nM, nN, nwg, G, c;
    __host__ __device__ void init(int M_, int N_, int G_, int c_) { nM = M_ / BM; nN = N_ / BM; nwg = nM * nN; G = G_; c = c_; }
    __host__ __device__ bool next(int i, Unit& u) const {
        const long L = (long)i * G + c; if (L >= nwg) return false;
        int wgid = (int)L; { const int q = nwg / NXCD, r = nwg % NXCD, xcd = wgid % NXCD, off = wgid / NXCD; wgid = (xcd < r ? xcd * (q + 1) : r * (q + 1) + (xcd - r) * q) + off; }
        const int nig = WGM * nN, gid = wgid / nig, fm = gid * WGM, gsz = (nM - fm) < WGM ? (nM - fm) : WGM;
        u.pm = fm + ((wgid % nig) % gsz); u.pn = (wgid % nig) / gsz; return true;
    }
};

__device__ __forceinline__ void prefetch_row_sums(const float* ss, const Unit& u, int wr, int fr, float (&raw)[8]) {
    if (ss) { const int row0 = u.pm * BM + wr * 64 + fr;
#pragma unroll
        for (int i = 0; i < 8; ++i) raw[i] = ss[row0 + (i >> 2) * HALF + (i & 3) * 16]; }
}
__device__ __forceinline__ void load_row_scales(const float* ss, const float (&raw)[8], float (&rs)[2][4]) {
#pragma unroll
    for (int ai = 0; ai < 2; ++ai)
#pragma unroll
        for (int m = 0; m < 4; ++m) rs[ai][m] = ss ? 1.0f / sqrtf(raw[ai * 4 + m] * (1.0f / DM) + EPS) : 1.0f;
}
struct EpiBf16 {
    bf16_t* O; int ldc; const float* bias; const float* ss;
    __device__ __forceinline__ void operator()(const f32x4 (&acc)[2][2][4][2], const Unit& u, int wr, int wc, int fr, int fq, const float (&raw)[8]) const {
        const int row0 = u.pm * BM + wr * 64 + fr; const int col0 = u.pn * BM + wc * 32 + 8 * fq;
        float rs[2][4]; load_row_scales(ss, raw, rs);
        f32x4 bv[2][2];
#pragma unroll
        for (int bj = 0; bj < 2; ++bj)
#pragma unroll
            for (int n = 0; n < 2; ++n) bv[bj][n] = bias ? *(const f32x4*)(bias + col0 + bj * HALF + 4 * n) : (f32x4){0.f, 0.f, 0.f, 0.f};
#pragma unroll
        for (int ai = 0; ai < 2; ++ai)
#pragma unroll
            for (int m = 0; m < 4; ++m) { bf16_t* rowp = O + (size_t)(row0 + ai * HALF + m * 16) * ldc + col0;
#pragma unroll
                for (int bj = 0; bj < 2; ++bj) { const f32x4 v0 = acc[ai][bj][m][0] * rs[ai][m] + bv[bj][0], v1 = acc[ai][bj][m][1] * rs[ai][m] + bv[bj][1];
                    u32x4 w; w.x = cvt_pk_bf16(v0[0], v0[1]); w.y = cvt_pk_bf16(v0[2], v0[3]); w.z = cvt_pk_bf16(v1[0], v1[1]); w.w = cvt_pk_bf16(v1[2], v1[3]);
                    *(u32x4*)(rowp + bj * HALF) = w; } }
    }
};
__device__ __forceinline__ f32x2 silu_pk(f32x2 g, f32x2 u, float rl, float ir2) {
    const f32x2 t = g * rl;
    f32x2 e; e.x = __builtin_amdgcn_exp2f(t.x); e.y = __builtin_amdgcn_exp2f(t.y);
    const f32x2 d = e * ir2 + ir2;
    f32x2 q; q.x = __builtin_amdgcn_rcpf(d.x); q.y = __builtin_amdgcn_rcpf(d.y);
    return (g * u) * q;
}
struct EpiSwiGLU {
    bf16_t* O; int ldc; const float* ss;
    __device__ __forceinline__ void operator()(const f32x4 (&acc)[2][2][4][2], const Unit& u, int wr, int wc, int fr, int fq, const float (&raw)[8]) const {
        const int row0 = u.pm * BM + wr * 64 + fr; const int col0 = u.pn * HALF + wc * 32 + 8 * fq;
#pragma unroll
        for (int ai = 0; ai < 2; ++ai)
#pragma unroll
            for (int m = 0; m < 4; ++m) { bf16_t* rowp = O + (size_t)(row0 + ai * HALF + m * 16) * ldc + col0;
                const float ir2 = ss ? raw[ai * 4 + m] * (1.0f / DM) + EPS : 1.0f; const float rl = -LOG2E / sqrtf(ir2);
                const f32x4 g0 = acc[ai][0][m][0], g1 = acc[ai][0][m][1], u0 = acc[ai][1][m][0], u1 = acc[ai][1][m][1];
                const f32x2 a = silu_pk((f32x2){g0[0], g0[1]}, (f32x2){u0[0], u0[1]}, rl, ir2), b = silu_pk((f32x2){g0[2], g0[3]}, (f32x2){u0[2], u0[3]}, rl, ir2);
                const f32x2 c = silu_pk((f32x2){g1[0], g1[1]}, (f32x2){u1[0], u1[1]}, rl, ir2), d = silu_pk((f32x2){g1[2], g1[3]}, (f32x2){u1[2], u1[3]}, rl, ir2);
                u32x4 w; w.x = cvt_pk_bf16(a.x, a.y); w.y = cvt_pk_bf16(b.x, b.y); w.z = cvt_pk_bf16(c.x, c.y); w.w = cvt_pk_bf16(d.x, d.y);
                *(u32x4*)rowp = w; }
    }
};
__device__ __forceinline__ float sig_mul(float a, float e) { return e * __builtin_amdgcn_rcpf(1.0f + __builtin_amdgcn_exp2f(-a * LOG2E)); }
struct EpiSigMul {
    bf16_t* O; const bf16_t* E; int ldc; const float* ss;
    __device__ __forceinline__ void operator()(const f32x4 (&acc)[2][2][4][2], const Unit& u, int wr, int wc, int fr, int fq, const float (&raw)[8]) const {
        const int row0 = u.pm * BM + wr * 64 + fr; const int col0 = u.pn * BM + wc * 32 + 8 * fq;
        float rs[2][4]; load_row_scales(ss, raw, rs);
#pragma unroll
        for (int ai = 0; ai < 2; ++ai) {
            u32x4 ev[4][2];
#pragma unroll
            for (int m = 0; m < 4; ++m)
#pragma unroll
                for (int bj = 0; bj < 2; ++bj) ev[m][bj] = *(const u32x4*)(E + (size_t)(row0 + ai * HALF + m * 16) * ldc + col0 + bj * HALF);
            asm volatile("" ::: "memory");
#pragma unroll
            for (int m = 0; m < 4; ++m) { const size_t off = (size_t)(row0 + ai * HALF + m * 16) * ldc + col0;
#pragma unroll
                for (int bj = 0; bj < 2; ++bj) { const f32x4 v0 = acc[ai][bj][m][0] * rs[ai][m], v1 = acc[ai][bj][m][1] * rs[ai][m]; const u32x4 e = ev[m][bj];
                    u32x4 w; w.x = cvt_pk_bf16(sig_mul(v0[0], bf_lo(e.x)), sig_mul(v0[1], bf_hi(e.x))); w.y = cvt_pk_bf16(sig_mul(v0[2], bf_lo(e.y)), sig_mul(v0[3], bf_hi(e.y)));
                    w.z = cvt_pk_bf16(sig_mul(v1[0], bf_lo(e.z)), sig_mul(v1[1], bf_hi(e.z))); w.w = cvt_pk_bf16(sig_mul(v1[2], bf_lo(e.w)), sig_mul(v1[3], bf_hi(e.w)));
                    *(u32x4*)(O + off + bj * HALF) = w; } }
            asm volatile("" ::: "memory");
        }
    }
};

template <class Epi>
__device__ __forceinline__ void gemm_phase(LAS unsigned char* lds, const Gemm g, const StaticOrder& S, const Epi& E) {
    const int tid = threadIdx.x, wid = __builtin_amdgcn_readfirstlane(tid >> 6), lane = tid & 63, wr = wid >> 2, wc = wid & 3, fr = lane & 15, fq = lane >> 4;
    const int K = g.K, nt = K / BK;
    unsigned voffA[2], voffB[2];
#pragma unroll
    for (int i = 0; i < 2; ++i) { int R, C; stage_rc(tid * 16 + i * 8192, R, C); const int Rb = (R & ~31) + perm32(R & 31);
        voffA[i] = (unsigned)(R * K + C) * 2u; voffB[i] = (unsigned)(Rb * K + C) * 2u; }
    const size_t kstep = (size_t)(BK * 2);
    const size_t hstep = (size_t)HALF * K * 2;
    const size_t tstep = 2 * hstep;
    const unsigned ldsw = (unsigned)wid * 1024u;
    const int aoff = lds_byte(wr * 64 + fr, fq * 8), boff = lds_byte(wc * 32 + fr, fq * 8);
#define PG8_SA(b, h) (((b) * 2 + (h)) * HTB)
#define PG8_SB(b, h) ((4 + (b) * 2 + (h)) * HTB)
#define PG8_STAGE(bufoff, gbase, voff) do { _Pragma("unroll") for (int _i = 0; _i < 2; ++_i) \
        __builtin_amdgcn_global_load_lds((const unsigned*)((const char*)(gbase) + (voff)[_i]), (LAS unsigned*)(lds + (bufoff) + ldsw + _i * 8192), 16, 0, 0); } while (0)
#define PG8_LDA(dst, b, h) do { _Pragma("unroll") for (int m = 0; m < 4; ++m) _Pragma("unroll") for (int k = 0; k < 2; ++k) dst[m][k] = *(const LAS bf16x8*)(lds + PG8_SA(b, h) + aoff + m * 2048 + k * 1024); } while (0)
#define PG8_LDB(dst, b, h) do { _Pragma("unroll") for (int n = 0; n < 2; ++n) _Pragma("unroll") for (int k = 0; k < 2; ++k) dst[n][k] = *(const LAS bf16x8*)(lds + PG8_SB(b, h) + boff + n * 2048 + k * 1024); } while (0)
#define PG8_MMA(ai, bj, At, Bt) do { __builtin_amdgcn_s_setprio(1); _Pragma("unroll") for (int m = 0; m < 4; ++m) _Pragma("unroll") for (int n = 0; n < 2; ++n) _Pragma("unroll") for (int k = 0; k < 2; ++k) \
        acc[ai][bj][m][n] = __builtin_amdgcn_mfma_f32_16x16x32_bf16(Bt[n][k], At[m][k], acc[ai][bj][m][n], 0, 0, 0); __builtin_amdgcn_s_setprio(0); } while (0)
#define PG8_WAIT_V(n) asm volatile("s_waitcnt vmcnt(" #n ")" ::: "memory")
#define PG8_WAIT_L(n) asm volatile("s_waitcnt lgkmcnt(" #n ")" ::: "memory")
#define PG8_BAR __builtin_amdgcn_s_barrier()
#define PG8_SCHED __builtin_amdgcn_sched_barrier(0)
    Unit cur, nxt; int ui = 0;
    if (!S.next(0, cur)) return;
    f32x4 acc[2][2][4][2];
#pragma unroll
    for (int a = 0; a < 2; ++a)
#pragma unroll
        for (int b = 0; b < 2; ++b)
#pragma unroll
            for (int m = 0; m < 4; ++m)
#pragma unroll
                for (int n = 0; n < 2; ++n) acc[a][b][m][n] = (f32x4){0.f, 0.f, 0.f, 0.f};
    bf16x8 At[4][2], B0[2][2], B1[2][2]; float raw[8] = {0.f, 0.f, 0.f, 0.f, 0.f, 0.f, 0.f, 0.f};
    const char* cA = (const char*)g.A + (size_t)cur.pm * tstep; const char* cB = (const char*)g.Bt + (size_t)cur.pn * tstep;
    const int rot = (((S.c & 7) * nt) >> 3) & ~1; const size_t rstep = (size_t)rot * kstep;
    PG8_STAGE(PG8_SB(0, 0), cB + rstep, voffB); PG8_STAGE(PG8_SB(0, 1), cB + rstep + hstep, voffB); PG8_STAGE(PG8_SA(0, 0), cA + rstep, voffA); PG8_STAGE(PG8_SA(0, 1), cA + rstep + hstep, voffA);
    if (wr == 1) PG8_BAR;
    PG8_WAIT_V(2); PG8_BAR;
    PG8_STAGE(PG8_SB(1, 0), cB + rstep + kstep, voffB); PG8_STAGE(PG8_SA(1, 0), cA + rstep + kstep, voffA); PG8_STAGE(PG8_SB(1, 1), cB + rstep + hstep + kstep, voffB);
    PG8_WAIT_V(6); PG8_BAR;
    for (;;) {
        const bool has_next = S.next(ui + 1, nxt);
        const char* nA = has_next ? (const char*)g.A + (size_t)nxt.pm * tstep : cA; const char* nB = has_next ? (const char*)g.Bt + (size_t)nxt.pn * tstep : cB;
        const int tmid = (nt >> 1) & ~1;
        for (int t = 0; t < nt; t += 2) {
            if (t == tmid) prefetch_row_sums(E.ss, cur, wr, fr, raw);
            const bool last = (t == nt - 2);
            int k0_ = t + rot; k0_ = k0_ >= nt ? k0_ - nt : k0_; int k2_ = t + 2 + rot; k2_ = k2_ >= nt ? k2_ - nt : k2_;
            const char* a1 = cA + (size_t)(k0_ + 1) * kstep;
            const char* a2 = last ? nA + rstep : cA + (size_t)k2_ * kstep; const char* b2 = last ? nB + rstep : cB + (size_t)k2_ * kstep;
            const char* a3 = a2 + kstep; const char* b3 = b2 + kstep;
            PG8_LDB(B0, 0, 0); PG8_LDB(B1, 0, 1); PG8_SCHED; PG8_LDA(At, 0, 0); PG8_STAGE(PG8_SA(1, 1), a1 + hstep, voffA);
            PG8_WAIT_V(8); PG8_WAIT_L(0); PG8_BAR; PG8_MMA(0, 0, At, B0); PG8_MMA(0, 1, At, B1); PG8_BAR; PG8_SCHED;
            PG8_LDA(At, 0, 1); PG8_STAGE(PG8_SB(0, 0), b2, voffB); PG8_STAGE(PG8_SB(0, 1), b2 + hstep, voffB); PG8_STAGE(PG8_SA(0, 0), a2, voffA);
            PG8_WAIT_V(8); PG8_WAIT_L(0); PG8_BAR; PG8_MMA(1, 0, At, B0); PG8_MMA(1, 1, At, B1); PG8_BAR; PG8_SCHED;
            PG8_LDB(B0, 1, 0); PG8_LDB(B1, 1, 1); PG8_SCHED; PG8_LDA(At, 1, 0); PG8_STAGE(PG8_SA(0, 1), a2 + hstep, voffA);
            PG8_WAIT_V(8); PG8_WAIT_L(0); PG8_BAR; PG8_MMA(0, 0, At, B0); PG8_MMA(0, 1, At, B1); PG8_BAR; PG8_SCHED;
            PG8_LDA(At, 1, 1); PG8_STAGE(PG8_SB(1, 0), b3, voffB); PG8_STAGE(PG8_SB(1, 1), b3 + hstep, voffB); PG8_STAGE(PG8_SA(1, 0), a3, voffA);
            PG8_WAIT_V(8); PG8_WAIT_L(0); PG8_BAR; PG8_MMA(1, 0, At, B0); PG8_MMA(1, 1, At, B1); PG8_BAR; PG8_SCHED;
        }
        if (wr == 0) PG8_BAR;
        E(acc, cur, wr, wc, fr, fq, raw);
        if (!has_next) break;
#pragma unroll
        for (int a = 0; a < 2; ++a)
#pragma unroll
            for (int b = 0; b < 2; ++b)
#pragma unroll
                for (int m = 0; m < 4; ++m)
#pragma unroll
                    for (int n = 0; n < 2; ++n) acc[a][b][m][n] = (f32x4){0.f, 0.f, 0.f, 0.f};
        cur = nxt; cA = nA; cB = nB; ++ui;
        if (wr == 1) PG8_BAR;
    }
    PG8_WAIT_V(0);
    PG8_BAR;
#undef PG8_SA
#undef PG8_SB
#undef PG8_STAGE
#undef PG8_LDA
#undef PG8_LDB
#undef PG8_MMA
#undef PG8_WAIT_V
#undef PG8_WAIT_L
#undef PG8_BAR
#undef PG8_SCHED
}
}

struct P0Item { const float* W; bf16_t* WT; const float* gk; int K, N, mode, item; };
__device__ __forceinline__ void p0_load(const P0Item& d, float (&wv)[32], int lane) {
    const int nblk = d.N / 32, kb = d.item / nblk, nb = d.item % nblk, k0 = 64 * kb, n0 = 32 * nb;
#pragma unroll
    for (int i = 0; i < 32; ++i) wv[i] = d.W[(size_t)(k0 + 2 * i + (lane >> 5)) * d.N + n0 + (lane & 31)];
}
__device__ __forceinline__ void p0_store(const P0Item& d, const float (&wv)[32], LAS float* scr, int lane) {
    const int nblk = d.N / 32, kb = d.item / nblk, nb = d.item % nblk, k0 = 64 * kb, n0 = 32 * nb;
    const int rb = (d.mode == 0) ? n0 : ((n0 >> 7) * 256 + (n0 & 127) + (d.mode == 2 ? 128 : 0));
#pragma unroll
    for (int i = 0; i < 32; ++i) scr[(2 * i + (lane >> 5)) * 33 + (lane & 31)] = wv[i];
    asm volatile("s_waitcnt lgkmcnt(0)" ::: "memory");
    const int c = lane & 7;
    f32x4 ga = (f32x4){1.f, 1.f, 1.f, 1.f}, gb = ga;
    if (d.gk) { ga = *(const f32x4*)(d.gk + k0 + 8 * c); gb = *(const f32x4*)(d.gk + k0 + 8 * c + 4); }
#pragma unroll
    for (int j = 0; j < 4; ++j) { const int n = (lane >> 3) + 8 * j; const LAS float* s = scr + (8 * c) * 33 + n;
        u32x4 o; o.x = cvt_pk_bf16(s[0 * 33] * ga.x, s[1 * 33] * ga.y); o.y = cvt_pk_bf16(s[2 * 33] * ga.z, s[3 * 33] * ga.w); o.z = cvt_pk_bf16(s[4 * 33] * gb.x, s[5 * 33] * gb.y); o.w = cvt_pk_bf16(s[6 * 33] * gb.z, s[7 * 33] * gb.w);
        *(u32x4*)(d.WT + (size_t)(rb + n) * d.K + k0 + 8 * c) = o; }
    asm volatile("s_waitcnt lgkmcnt(0)" ::: "memory");
}

__device__ __forceinline__ void rms_row_process(const f32x4 (&v)[8], float* ss, bf16_t* XN, int m, int lane) {
    float s = 0.f;
    u32x2* o = (u32x2*)(XN + (size_t)m * DM) + lane;
#pragma unroll
    for (int j = 0; j < 8; ++j) { u32x2 w; w.x = cvt_pk_bf16(v[j].x, v[j].y); w.y = cvt_pk_bf16(v[j].z, v[j].w); o[64 * j] = w;
        const f32x4 q = (f32x4){bf_lo(w.x), bf_hi(w.x), bf_lo(w.y), bf_hi(w.y)}; s += (q.x * q.x + q.y * q.y) + (q.z * q.z + q.w * q.w); }
    s = wave_sum(s); if (lane == 0) ss[m] = s;
}
__device__ __forceinline__ void rms_rows(const float* X, float* g, bf16_t* XN, int gw, int NGW, int lane, int M = ::M) {
    f32x4 A[8], B[8];
    int m = gw;
#define RMS_LOAD(R, mm) do { const f32x4* xr_ = (const f32x4*)(X + (size_t)(mm) * DM) + lane; _Pragma("unroll") for (int j = 0; j < 8; ++j) R[j] = xr_[64 * j]; } while (0)
    if (m < M) RMS_LOAD(A, m);
    while (m < M) {
        const int m1 = m + NGW, m2 = m1 + NGW;
        if (m1 < M) RMS_LOAD(B, m1);
        rms_row_process(A, g, XN, m, lane);
        if (m1 >= M) break;
        if (m2 < M) RMS_LOAD(A, m2);
        rms_row_process(B, g, XN, m1, lane);
        m = m2;
    }
#undef RMS_LOAD
}

template <bool IN16> struct RowRegs { u32x2 f[8]; f32x4 h[IN16 ? 1 : 8]; u32x2 h16[IN16 ? 8 : 1]; };
template <bool IN16>
__device__ __forceinline__ void row_load(RowRegs<IN16>& R, const bf16_t* F, const void* Hin, int m, int lane) {
    const u32x2* fp = (const u32x2*)(F + (size_t)m * DM) + lane;
#pragma unroll
    for (int j = 0; j < 8; ++j) { R.f[j] = fp[64 * j];
        if (IN16) R.h16[j] = ((const u32x2*)((const bf16_t*)Hin + (size_t)m * DM) + lane)[64 * j];
        else R.h[j] = ((const f32x4*)((const float*)Hin + (size_t)m * DM) + lane)[64 * j]; }
}
template <bool IN16, bool OUT16>
__device__ __forceinline__ void row_process(const RowRegs<IN16>& R, const float* gpost, float alpha, void* Hout, float* ss, int m, int lane) {
    f32x4 f[8], h[8]; float s = 0.f;
#pragma unroll
    for (int j = 0; j < 8; ++j) { const u32x2 w = R.f[j]; f[j] = (f32x4){bf_lo(w.x), bf_hi(w.x), bf_lo(w.y), bf_hi(w.y)};
        if (IN16) { const u32x2 hw = R.h16[j]; h[j] = (f32x4){bf_lo(hw.x), bf_hi(hw.x), bf_lo(hw.y), bf_hi(hw.y)}; } else h[j] = R.h[j];
        s += (f[j].x * f[j].x + f[j].y * f[j].y) + (f[j].z * f[j].z + f[j].w * f[j].w); }
    const float r1 = alpha / sqrtf(wave_sum(s) * (1.0f / DM) + EPS);
    float s2 = 0.f;
#pragma unroll
    for (int j = 0; j < 8; ++j) { const f32x4 gg = ((const f32x4*)gpost)[lane + 64 * j]; h[j] = h[j] + f[j] * gg * r1;
        if (OUT16) { u32x2 w; w.x = cvt_pk_bf16(h[j].x, h[j].y); w.y = cvt_pk_bf16(h[j].z, h[j].w); ((u32x2*)((bf16_t*)Hout + (size_t)m * DM) + lane)[64 * j] = w;
            h[j] = (f32x4){bf_lo(w.x), bf_hi(w.x), bf_lo(w.y), bf_hi(w.y)}; }
        else ((f32x4*)((float*)Hout + (size_t)m * DM) + lane)[64 * j] = h[j];
        s2 += (h[j].x * h[j].x + h[j].y * h[j].y) + (h[j].z * h[j].z + h[j].w * h[j].w); }
    if (ss) { s2 = wave_sum(s2); if (lane == 0) ss[m] = s2; }
}
template <bool IN16, bool OUT16>
__device__ __forceinline__ void rowpass(const bf16_t* F, const float* gpost, float alpha, const void* Hin, void* Hout, float* ss, int gw, int NGW, int lane, int M = ::M) {
    RowRegs<IN16> A, B;
    int m = gw;
    if (m < M) row_load<IN16>(A, F, Hin, m, lane);
    while (m < M) {
        const int m1 = m + NGW, m2 = m1 + NGW;
        if (m1 < M) row_load<IN16>(B, F, Hin, m1, lane);
        row_process<IN16, OUT16>(A, gpost, alpha, Hout, ss, m, lane);
        if (m1 >= M) break;
        if (m2 < M) row_load<IN16>(A, F, Hin, m2, lane);
        row_process<IN16, OUT16>(B, gpost, alpha, Hout, ss, m1, lane);
        m = m2;
    }
}

constexpr int ATT_NA = BATCH * 16 * 3 * 16, ATT_NB = BATCH * 16 * 16, ATT_NU = ATT_NA + ATT_NB;
struct AttU { int b, qcol, kcol, vcol, dsh, r, blk, wmax, ocol, hidx, br, isA; float slope, sink2; };
__device__ __forceinline__ void att_decode(int u, float sinkv, AttU& a) {
    if (u < ATT_NA) { const int x = u & 15, t = u >> 4, br = t % 3, bh = t / 3, h = bh & 15; a.b = bh >> 4; a.dsh = 2 * br; a.r = x & ((1 << a.dsh) - 1); a.blk = x >> a.dsh;
        a.qcol = h * 64; a.kcol = 1024 + h * 64; a.vcol = 2048 + h * 64; a.wmax = 128; a.slope = __builtin_amdgcn_exp2f(-(float)(2 * h + 1) * 0.25f); a.sink2 = -INFINITY; a.isA = 1; a.br = br; a.ocol = h * 64; a.hidx = h; }
    else { const int v = u - ATT_NA; a.blk = v & 15; const int hq = (v >> 4) & 15; a.b = v >> 8; a.dsh = 0; a.r = 0;
        a.qcol = 3072 + hq * 64; a.kcol = 4096 + (hq >> 3) * 64; a.vcol = 4224 + (hq >> 3) * 64; a.wmax = 127; a.slope = __builtin_amdgcn_exp2f(-(float)(hq + 1) * 0.5f); a.sink2 = __builtin_bit_cast(float, __builtin_amdgcn_readlane(__builtin_bit_cast(int, sinkv), hq)) * LOG2E; a.isA = 0; a.br = 0; a.ocol = hq * 64; a.hidx = hq; }
}
typedef short bf16x4 __attribute__((ext_vector_type(4)));
__device__ __forceinline__ int att_unit_xcd(int p, int xcd, bool xl) {
    if (p >= 2048) return ATT_NU;
    if (p < 1536) { const int gi = p / 48, within = p % 48, bh = xl ? 32 * xcd + gi : gi * 8 + xcd; return (bh * 3 + within / 16) * 16 + (within & 15); }
    const int pb = p - 1536, lin = xl ? 4 * xcd + (pb >> 7) : (pb >> 7) * 8 + xcd, within = pb & 127, b = lin >> 1, hq = (lin & 1) * 8 + (within >> 4);
    return ATT_NA + (b * 16 + hq) * 16 + (within & 15);
}
__device__ __forceinline__ float xrow16_max(float x) {
  auto s = __builtin_amdgcn_permlane16_swap(__float_as_uint(x), __float_as_uint(x), false, false);
  x = fmaxf(__uint_as_float(s[0]), __uint_as_float(s[1]));
  auto t = __builtin_amdgcn_permlane32_swap(__float_as_uint(x), __float_as_uint(x), false, false);
  return fmaxf(__uint_as_float(t[0]), __uint_as_float(t[1]));
}
__device__ __forceinline__ float xrow16_sum(float x) {
  auto s = __builtin_amdgcn_permlane16_swap(__float_as_uint(x), __float_as_uint(x), false, false);
  x = __uint_as_float(s[0]) + __uint_as_float(s[1]);
  auto t = __builtin_amdgcn_permlane32_swap(__float_as_uint(x), __float_as_uint(x), false, false);
  return __uint_as_float(t[0]) + __uint_as_float(t[1]);
}
#define ATT_TR8(v, vb, o0, o1) asm volatile( \
    "ds_read_b64_tr_b16 %0, %8 offset:%12\n\tds_read_b64_tr_b16 %1, %8 offset:%13\n\tds_read_b64_tr_b16 %2, %9 offset:%12\n\tds_read_b64_tr_b16 %3, %9 offset:%13\n\t" \
    "ds_read_b64_tr_b16 %4, %10 offset:%12\n\tds_read_b64_tr_b16 %5, %10 offset:%13\n\tds_read_b64_tr_b16 %6, %11 offset:%12\n\tds_read_b64_tr_b16 %7, %11 offset:%13" \
    : "=&v"(v[0][0]), "=&v"(v[0][1]), "=&v"(v[1][0]), "=&v"(v[1][1]), "=&v"(v[2][0]), "=&v"(v[2][1]), "=&v"(v[3][0]), "=&v"(v[3][1]) \
    : "v"(vb[0]), "v"(vb[1]), "v"(vb[2]), "v"(vb[3]), "i"(o0), "i"(o1) : "memory")
#define ATT_TR4(v, vb, o0) asm volatile( \
    "ds_read_b64_tr_b16 %0, %4 offset:%8\n\tds_read_b64_tr_b16 %1, %5 offset:%8\n\tds_read_b64_tr_b16 %2, %6 offset:%8\n\tds_read_b64_tr_b16 %3, %7 offset:%8" \
    : "=&v"(v[0]), "=&v"(v[1]), "=&v"(v[2]), "=&v"(v[3]) : "v"(vb[0]), "v"(vb[1]), "v"(vb[2]), "v"(vb[3]), "i"(o0) : "memory")
#define ATT_TOUCH8(v) "+v"(v[0][0]), "+v"(v[0][1]), "+v"(v[1][0]), "+v"(v[1][1]), "+v"(v[2][0]), "+v"(v[2][1]), "+v"(v[3][0]), "+v"(v[3][1])
template <bool SKIP>
__device__ __forceinline__ void att_compute(unsigned kb0, unsigned kb1, const unsigned (&vb)[4], bf16x8 q0, bf16x8 q1, float slope2, float sink2, int wmax, int kt_lo, int fr, int fq,
                                            u32x2 (&outO)[4], float& outlse) {
    const float c1 = 0.125f * LOG2E;
    float LBj[4]; int relj[4];
#pragma unroll
    for (int j = 0; j < 4; ++j) { relj[j] = fr - 4 * fq - j; LBj[j] = -slope2 * (float)relj[j]; }
    const f32x4 LB4 = (f32x4){LBj[0], LBj[1], LBj[2], LBj[3]};
    bf16x8 kf[9][2];
#pragma unroll
    for (int kt = 0; kt < 9; ++kt) { kf[kt][0] = *(const LAS bf16x8*)(size_t)(kb0 + kt * 2048); kf[kt][1] = *(const LAS bf16x8*)(size_t)(kb1 + kt * 2048); }
    f32x4 S[9];
#pragma unroll
    for (int kt = 0; kt < 9; ++kt) S[kt] = __builtin_amdgcn_mfma_f32_16x16x32_bf16(kf[kt][0], q0, (f32x4){0.f, 0.f, 0.f, 0.f}, 0, 0, 0);
#pragma unroll
    for (int kt = 0; kt < 9; ++kt) S[kt] = __builtin_amdgcn_mfma_f32_16x16x32_bf16(kf[kt][1], q1, S[kt], 0, 0, 0);
    bf16x4 vt0[4][2], vt1[4][2], vt2[4][2], vt3[4][2], vt8[4];
    ATT_TR8(vt0, vb, 0 * 2048, 1 * 2048); ATT_TR8(vt1, vb, 2 * 2048, 3 * 2048); ATT_TR8(vt2, vb, 4 * 2048, 5 * 2048); ATT_TR8(vt3, vb, 6 * 2048, 7 * 2048); ATT_TR4(vt8, vb, 8 * 2048);
    float mx = -INFINITY;
#pragma unroll
    for (int kt = 0; kt < 9; ++kt) {
        f32x4 v = S[kt] * c1 + LB4;
#pragma unroll
        for (int j = 0; j < 4; ++j) {
            if (kt == 0) v[j] = (128 + relj[j] <= wmax) ? v[j] : -INFINITY;
            if (kt == 8) v[j] = (relj[j] >= 0) ? v[j] : -INFINITY;
            if (SKIP && kt < 8) v[j] = (kt >= kt_lo) ? v[j] : -INFINITY; }
        S[kt] = v;
        const float tb = slope2 * (float)(16 * kt - 128);
        mx = fmaxf(mx, fmaxf(fmaxf(v[0], v[1]), fmaxf(v[2], v[3])) + tb); }
    mx = xrow16_max(mx);
    mx = fmaxf(mx, sink2);
    f32x4 sm4 = (f32x4){0.f, 0.f, 0.f, 0.f};
#pragma unroll
    for (int kt = 0; kt < 9; ++kt) {
        const float mk = mx - slope2 * (float)(16 * kt - 128);
        const f32x4 dlt = S[kt] - mk; f32x4 p;
#pragma unroll
        for (int j = 0; j < 4; ++j) p[j] = __builtin_amdgcn_exp2f(dlt[j]);
        S[kt] = p; sm4 += p; }
    float sm = (sm4[0] + sm4[1]) + (sm4[2] + sm4[3]);
    sm = xrow16_sum(sm);
    sm += __builtin_amdgcn_exp2f(sink2 - mx);
    const float inv = 1.0f / sm;
    bf16x8 P[4];
#pragma unroll
    for (int c = 0; c < 4; ++c) { u32x4 pw; pw.x = cvt_pk_bf16(S[2 * c][0], S[2 * c][1]); pw.y = cvt_pk_bf16(S[2 * c][2], S[2 * c][3]);
        pw.z = cvt_pk_bf16(S[2 * c + 1][0], S[2 * c + 1][1]); pw.w = cvt_pk_bf16(S[2 * c + 1][2], S[2 * c + 1][3]); P[c] = __builtin_bit_cast(bf16x8, pw); }
    u32x2 pw8; pw8.x = cvt_pk_bf16(S[8][0], S[8][1]); pw8.y = cvt_pk_bf16(S[8][2], S[8][3]);
    const bf16x4 P4 = __builtin_bit_cast(bf16x4, pw8);
    asm volatile("s_waitcnt lgkmcnt(0)" : ATT_TOUCH8(vt0), ATT_TOUCH8(vt1) :: "memory");
    asm volatile("" : ATT_TOUCH8(vt2), ATT_TOUCH8(vt3), "+v"(vt8[0]), "+v"(vt8[1]), "+v"(vt8[2]), "+v"(vt8[3]) :: "memory");
    f32x4 O[4];
#pragma unroll
    for (int dt = 0; dt < 4; ++dt) O[dt] = __builtin_amdgcn_mfma_f32_16x16x32_bf16(__builtin_shufflevector(vt0[dt][0], vt0[dt][1], 0, 1, 2, 3, 4, 5, 6, 7), P[0], (f32x4){0.f, 0.f, 0.f, 0.f}, 0, 0, 0);
#pragma unroll
    for (int dt = 0; dt < 4; ++dt) O[dt] = __builtin_amdgcn_mfma_f32_16x16x32_bf16(__builtin_shufflevector(vt1[dt][0], vt1[dt][1], 0, 1, 2, 3, 4, 5, 6, 7), P[1], O[dt], 0, 0, 0);
#pragma unroll
    for (int dt = 0; dt < 4; ++dt) O[dt] = __builtin_amdgcn_mfma_f32_16x16x32_bf16(__builtin_shufflevector(vt2[dt][0], vt2[dt][1], 0, 1, 2, 3, 4, 5, 6, 7), P[2], O[dt], 0, 0, 0);
#pragma unroll
    for (int dt = 0; dt < 4; ++dt) O[dt] = __builtin_amdgcn_mfma_f32_16x16x32_bf16(__builtin_shufflevector(vt3[dt][0], vt3[dt][1], 0, 1, 2, 3, 4, 5, 6, 7), P[3], O[dt], 0, 0, 0);
#pragma unroll
    for (int dt = 0; dt < 4; ++dt) O[dt] = __builtin_amdgcn_mfma_f32_16x16x16bf16_1k(vt8[dt], P4, O[dt], 0, 0, 0);
#pragma unroll
    for (int dt = 0; dt < 4; ++dt) { const f32x4 o = O[dt] * inv; outO[dt].x = cvt_pk_bf16(o[0], o[1]); outO[dt].y = cvt_pk_bf16(o[2], o[3]); }
    outlse = (mx + __log2f(sm)) * LN2;
}

constexpr int ATT_BUF = 65536;
__device__ __forceinline__ void attn_phase(LAS unsigned char* lds, const bf16_t* Z, bf16_t* OAp, float* LSEp, bf16_t* OBp, const float* sinks, int G, int vc, bool xl) {
    const int tid = threadIdx.x, lane = tid & 63, fr = lane & 15, fq = lane >> 4;
    const int wv = __builtin_amdgcn_readfirstlane(tid >> 6);
    const int drow = lane >> 3, dchunk = (lane & 7) ^ drow;
    const unsigned koff0 = (unsigned)((16 * wv + fr) * 128 + ((fq ^ (fr & 7) ^ (fr >> 3)) * 16)), koff1 = koff0 ^ 64u;
    const int vq = (lane & 15) >> 2, vp = lane & 3, vrow = 4 * fq + vq;
    unsigned voff[4];
#pragma unroll
    for (int dt = 0; dt < 4; ++dt) voff[dt] = (unsigned)((16 * wv + vrow) * 128 + (((2 * dt + (vp >> 1)) ^ (vrow & 7) ^ (vrow >> 3)) * 16) + 8 * (vp & 1));
    bf16x8 Qn[2];
    AttU cu;
    const float sinkv = sinks[lane & 15];
#define ATT_ISSUE(a, bufb) do { const size_t rowbase_ = (size_t)(a).b * SEQ; \
        _Pragma("unroll") for (int ks = 0; ks < 2; ++ks) \
            Qn[ks] = *(const bf16x8*)(Z + (rowbase_ + ((((a).blk * 128 + 16 * wv + fr) << (a).dsh) + (a).r)) * NQKV + (a).qcol + ks * 32 + fq * 8); \
        _Pragma("unroll") for (int i = 0; i < 4; ++i) { const int rg = wv * 4 + i; int fj = (a).blk * 128 - 128 + 8 * rg + drow; fj = fj < 0 ? 0 : fj; \
            const bf16_t* gp = Z + (rowbase_ + (fj << (a).dsh) + (a).r) * NQKV + (dchunk ^ (i & 1)) * 8; \
            __builtin_amdgcn_global_load_lds((const unsigned*)(gp + (a).kcol), (LAS unsigned*)((bufb) + rg * 1024), 16, 0, 0); \
            __builtin_amdgcn_global_load_lds((const unsigned*)(gp + (a).vcol), (LAS unsigned*)((bufb) + 32768 + rg * 1024), 16, 0, 0); } } while (0)
    const bool xmap = (G == 256); const int xcd = vc & 7, cix = vc >> 3;
#define ATT_UNIT(it_) (xmap ? att_unit_xcd((it_) * 32 + cix, xcd, xl) : ((long)(it_) * G + vc < ATT_NU ? (int)((it_) * G + vc) : ATT_NU))
    int u = ATT_UNIT(0);
    if (u < ATT_NU) { att_decode(u, sinkv, cu); ATT_ISSUE(cu, lds); }
    __syncthreads();
    u32x2 pendO[4]; bf16_t* pendp = nullptr; float* pendl = nullptr; float pendlse = 0.f;
    for (int it = 0; u < ATT_NU; ++it) {
        const int unext = ATT_UNIT(it + 1);
        LAS unsigned char* Kb = lds + (it & 1) * ATT_BUF; LAS unsigned char* Vb = Kb + 32768;
        const bf16x8 q0 = Qn[0], q1 = Qn[1];
        AttU nu = cu;
        if (unext < ATT_NU) { att_decode(unext, sinkv, nu); ATT_ISSUE(nu, lds + ((it + 1) & 1) * ATT_BUF); }
        if (pendp) {
#pragma unroll
            for (int dt = 0; dt < 4; ++dt) *(u32x2*)(pendp + dt * 16) = pendO[dt];
            if (pendl) *pendl = pendlse; }
        { const int t = ((cu.blk * 128 + 16 * wv + fr) << cu.dsh) + cu.r; const size_t row = (size_t)cu.b * SEQ + t;
          bf16_t* Op = cu.isA ? OAp + (size_t)cu.br * M * AW : OBp;
          pendp = Op + row * AW + cu.ocol + fq * 4;
          pendl = (cu.isA && fq == 0) ? LSEp + ((size_t)cu.br * M + row) * 16 + cu.hidx : nullptr;
          const float slope2 = cu.slope * (float)(1 << cu.dsh) * LOG2E;
          const unsigned kb0 = (unsigned)(size_t)Kb + koff0, kb1 = (unsigned)(size_t)Kb + koff1;
          unsigned vb[4];
#pragma unroll
          for (int dt = 0; dt < 4; ++dt) vb[dt] = (unsigned)(size_t)Vb + voff[dt];
          if (cu.blk != 0) att_compute<false>(kb0, kb1, vb, q0, q1, slope2, cu.sink2, cu.wmax, 0, fr, fq, pendO, pendlse);
          else att_compute<true>(kb0, kb1, vb, q0, q1, slope2, cu.sink2, cu.wmax, 8 - wv, fr, fq, pendO, pendlse); }
        __syncthreads();
        cu = nu; u = unext;
    }
    if (pendp) {
#pragma unroll
        for (int dt = 0; dt < 4; ++dt) *(u32x2*)(pendp + dt * 16) = pendO[dt];
        if (pendl) *pendl = pendlse; }
    __syncthreads();
#undef ATT_ISSUE
#undef ATT_UNIT
}

struct CombRegs { u32x4 a[3][2]; u32x4 b[2]; float l[3]; };
__device__ __forceinline__ void comb_load(CombRegs& R, const bf16_t* OA, const float* LSE, const bf16_t* OB, int m, int lane) {
    const int h = lane >> 2;
#pragma unroll
    for (int br = 0; br < 3; ++br) { R.l[br] = LSE[((size_t)br * M + m) * 16 + h];
#pragma unroll
        for (int hf = 0; hf < 2; ++hf) R.a[br][hf] = *(const u32x4*)(OA + ((size_t)br * M + m) * AW + lane * 16 + hf * 8); }
#pragma unroll
    for (int hf = 0; hf < 2; ++hf) R.b[hf] = *(const u32x4*)(OB + (size_t)m * AW + lane * 16 + hf * 8);
}
__device__ __forceinline__ void comb_process(const CombRegs& R, const float* gA, const float* gB, bf16_t* XN, int m, int lane) {
    const float mx = fmaxf(R.l[0], fmaxf(R.l[1], R.l[2])); float w0 = __expf(R.l[0] - mx), w1 = __expf(R.l[1] - mx), w2 = __expf(R.l[2] - mx); const float ws = 1.0f / (w0 + w1 + w2); w0 *= ws; w1 *= ws; w2 *= ws;
    float oa[16], ob[16]; float sa = 0.f, sb = 0.f;
#pragma unroll
    for (int hf = 0; hf < 2; ++hf) {
        const u32x4 a0 = R.a[0][hf], a1 = R.a[1][hf], a2 = R.a[2][hf], bq = R.b[hf];
#pragma unroll
        for (int e = 0; e < 4; ++e) {
            oa[hf * 8 + 2 * e] = w0 * bf_lo(a0[e]) + w1 * bf_lo(a1[e]) + w2 * bf_lo(a2[e]); oa[hf * 8 + 2 * e + 1] = w0 * bf_hi(a0[e]) + w1 * bf_hi(a1[e]) + w2 * bf_hi(a2[e]);
            ob[hf * 8 + 2 * e] = bf_lo(bq[e]); ob[hf * 8 + 2 * e + 1] = bf_hi(bq[e]); }
    }
#pragma unroll
    for (int e = 0; e < 16; ++e) { sa += oa[e] * oa[e]; sb += ob[e] * ob[e]; }
    const float ra = 1.0f / sqrtf(wave_sum(sa) * (1.0f / AW) + EPS), rb = 1.0f / sqrtf(wave_sum(sb) * (1.0f / AW) + EPS);
#pragma unroll
    for (int hf = 0; hf < 2; ++hf) {
        const f32x4 ga0 = *(const f32x4*)(gA + lane * 16 + hf * 8), ga1 = *(const f32x4*)(gA + lane * 16 + hf * 8 + 4), gb0 = *(const f32x4*)(gB + lane * 16 + hf * 8), gb1 = *(const f32x4*)(gB + lane * 16 + hf * 8 + 4);
        u32x4 wa, wb;
        wa.x = cvt_pk_bf16(oa[hf * 8 + 0] * ra * ga0.x, oa[hf * 8 + 1] * ra * ga0.y); wa.y = cvt_pk_bf16(oa[hf * 8 + 2] * ra * ga0.z, oa[hf * 8 + 3] * ra * ga0.w);
        wa.z = cvt_pk_bf16(oa[hf * 8 + 4] * ra * ga1.x, oa[hf * 8 + 5] * ra * ga1.y); wa.w = cvt_pk_bf16(oa[hf * 8 + 6] * ra * ga1.z, oa[hf * 8 + 7] * ra * ga1.w);
        wb.x = cvt_pk_bf16(ob[hf * 8 + 0] * rb * gb0.x, ob[hf * 8 + 1] * rb * gb0.y); wb.y = cvt_pk_bf16(ob[hf * 8 + 2] * rb * gb0.z, ob[hf * 8 + 3] * rb * gb0.w);
        wb.z = cvt_pk_bf16(ob[hf * 8 + 4] * rb * gb1.x, ob[hf * 8 + 5] * rb * gb1.y); wb.w = cvt_pk_bf16(ob[hf * 8 + 6] * rb * gb1.z, ob[hf * 8 + 7] * rb * gb1.w);
        *(u32x4*)(XN + (size_t)m * DM + lane * 16 + hf * 8) = wa; *(u32x4*)(XN + (size_t)m * DM + AW + lane * 16 + hf * 8) = wb; }
}
__device__ __forceinline__ void combine_rows(const bf16_t* OA, const float* LSE, const bf16_t* OB, const float* gA, const float* gB, bf16_t* XN, int gw, int NGW, int lane, int M = ::M) {
    CombRegs A, B;
    int m = gw;
    if (m < M) comb_load(A, OA, LSE, OB, m, lane);
    while (m < M) {
        const int m1 = m + NGW, m2 = m1 + NGW;
        if (m1 < M) comb_load(B, OA, LSE, OB, m1, lane);
        comb_process(A, gA, gB, XN, m, lane);
        if (m1 >= M) break;
        if (m2 < M) comb_load(A, OA, LSE, OB, m2, lane);
        comb_process(B, gA, gB, XN, m1, lane);
        m = m2;
    }
}

#define XB_TMO      128
#define XB_XCNT(j)  (256  + 64 * (j))
#define XB_XSUB(j)  (1280 + 64 * (j))
#define XB_XGEN(j)  (2304 + 64 * (j))
#define XB_TOP      3328
#define XB_TOPGEN   3392
#define XCD_BAR_WORDS 3456
#define XB_SPIN_CAP (1u << 18)
__device__ __forceinline__ unsigned xb_ld(unsigned* p)              { return __hip_atomic_load(p, __ATOMIC_RELAXED, __HIP_MEMORY_SCOPE_AGENT); }
__device__ __forceinline__ unsigned xb_add(unsigned* p, unsigned v) { return __hip_atomic_fetch_add(p, v, __ATOMIC_RELAXED, __HIP_MEMORY_SCOPE_AGENT); }
__device__ __forceinline__ unsigned xb_xcc_id() { return (unsigned)__builtin_amdgcn_s_getreg((3 << 11) | 20) & 0xFu; }
#define XB_SPIN(cond, bar) do { unsigned _sp = 0; while (cond) { __builtin_amdgcn_s_sleep(1); \
    if ((++_sp & 255u) == 0u) { if (xb_ld(&(bar)[XB_TMO])) break; if (_sp > XB_SPIN_CAP) { atomicAdd(&(bar)[XB_TMO], 1u); break; } } } } while (0)
struct XcdBarrier { unsigned* bar; unsigned x; volatile LAS unsigned* st; };
__device__ __forceinline__ XcdBarrier xcd_barrier_post(unsigned* bar, volatile LAS unsigned* st) {
    XcdBarrier b; b.bar = bar; b.x = xb_xcc_id(); b.st = st;
    if (threadIdx.x == 0) (void)xb_add(&bar[XB_XCNT(b.x)], 1u);
    return b;
}
__device__ __forceinline__ void xcd_barrier_complete(unsigned* bar, unsigned x, unsigned& nloc, unsigned& nx) {
    const unsigned G = gridDim.x * gridDim.y * gridDim.z;
    unsigned sum, cnt, mine, sp = 0u;
    for (;;) {
        sum = 0u; cnt = 0u; mine = 0u;
#pragma unroll
        for (unsigned j = 0; j < 16; ++j) { const unsigned c = xb_ld(&bar[XB_XCNT(j)]); sum += c; cnt += (c > 0u) ? 1u : 0u; mine = (j == x) ? c : mine; }
        if (sum == G) break;
        __builtin_amdgcn_s_sleep(1);
        if ((++sp & 255u) == 0u) { if (xb_ld(&bar[XB_TMO])) break; if (sp > XB_SPIN_CAP) { atomicAdd(&bar[XB_TMO], 1u); break; } }
    }
    nloc = mine > 0u ? mine : 1u; nx = cnt > 0u ? cnt : 1u;
}
__device__ __forceinline__ void xcd_barrier(const XcdBarrier& b) {
    asm volatile("s_waitcnt vmcnt(0)" ::: "memory");
    __syncthreads();
    if (threadIdx.x == 0) {
        unsigned* bar = b.bar;
        __builtin_amdgcn_s_waitcnt(0);
        unsigned nloc = b.st[0], nx = b.st[1];
        if (nloc == 0u) { xcd_barrier_complete(bar, b.x, nloc, nx); b.st[0] = nloc; b.st[1] = nx; }
        const unsigned old = xb_add(&bar[XB_XSUB(b.x)], 1u);
        const unsigned gen = old / nloc;
        if (old + 1u == (gen + 1u) * nloc) {
            __builtin_amdgcn_fence(__ATOMIC_RELEASE, "agent");
            asm volatile("s_waitcnt vmcnt(0)" ::: "memory");
            const unsigned og = xb_add(&bar[XB_TOP], 1u);
            const unsigned tg = og / nx;
            if (og + 1u == (tg + 1u) * nx) xb_add(&bar[XB_TOPGEN], 1u);
            else XB_SPIN(xb_ld(&bar[XB_TOPGEN]) == tg, bar);
            __builtin_amdgcn_fence(__ATOMIC_ACQUIRE, "agent");
            xb_add(&bar[XB_XGEN(b.x)], 1u);
            asm volatile("s_waitcnt vmcnt(0)" ::: "memory");
        } else {
            XB_SPIN(xb_ld(&bar[XB_XGEN(b.x)]) == gen, bar);
            __builtin_amdgcn_fence(__ATOMIC_ACQUIRE, "agent");
            asm volatile("s_waitcnt vmcnt(0)" ::: "memory");
        }
    }
    __syncthreads();
}

#define XL_SUB(j)  (4096 + 64 * (j))
#define XL_GEN(j)  (4608 + 64 * (j))
#define XL_CNT(j)  (5120 + 64 * (j))
__device__ __forceinline__ void xl_barrier(unsigned* bar, unsigned x, unsigned nloc) {
    asm volatile("s_waitcnt vmcnt(0)" ::: "memory");
    __syncthreads();
    if (threadIdx.x == 0) {
        __builtin_amdgcn_s_waitcnt(0);
        const unsigned old = xb_add(&bar[XL_SUB(x)], 1u);
        const unsigned gen = old / nloc;
        if (old + 1u == (gen + 1u) * nloc) xb_add(&bar[XL_GEN(x)], 1u);
        else XB_SPIN(xb_ld(&bar[XL_GEN(x)]) == gen, bar);
        __builtin_amdgcn_fence(__ATOMIC_ACQUIRE, "agent");
        asm volatile("s_waitcnt vmcnt(0)" ::: "memory");
    }
    __syncthreads();
}

enum { I_X = 0, I_P, I_G1PRE, I_W1G, I_W1U, I_W1D, I_G1POST, I_GMIXPRE, I_WQKV, I_BQKV, I_SINKS, I_GOA, I_GOB, I_WO, I_BO, I_GMIXPOST, I_G2PRE, I_W2G, I_W2U, I_W2D, I_G2POST, I_GPLEPRE, I_WPG, I_WPP, I_GPLEPOST, N_IN };
struct Args { const float* in[N_IN]; float* out; unsigned char* ws; int ph_lo, ph_hi; };
constexpr int N_PHASES = 14;

__global__ void __launch_bounds__(512, 2) mk_fwd(Args args) {
    extern __shared__ __attribute__((aligned(16))) unsigned char lds_raw[];
    LAS unsigned char* lds = (LAS unsigned char*)lds_raw;
    cg::grid_group grid = cg::this_grid();
    const int tid = threadIdx.x, lane = tid & 63, wave = __builtin_amdgcn_readfirstlane(tid >> 6);
    const int G = gridDim.x, gw = blockIdx.x * 8 + wave, NGW = G * 8;
    unsigned char* ws = args.ws;
#define W1GU ((bf16_t*)(ws + WS_W1GU))
#define W1D ((bf16_t*)(ws + WS_W1D))
#define W2GU ((bf16_t*)(ws + WS_W2GU))
#define W2D ((bf16_t*)(ws + WS_W2D))
#define WQKV ((bf16_t*)(ws + WS_WQKV))
#define WO ((bf16_t*)(ws + WS_WO))
#define WG ((bf16_t*)(ws + WS_WG))
#define WP ((bf16_t*)(ws + WS_WP))
#define XN ((bf16_t*)(ws + WS_XN))
#define ACT ((bf16_t*)(ws + WS_ACT))
#define Zb ((bf16_t*)(ws + WS_Z))
#define OB ((bf16_t*)(ws + WS_OB))
#define Fb ((bf16_t*)(ws + WS_F))
#define OA ((bf16_t*)(ws + WS_OA))
#define LSE ((float*)(ws + WS_LSE))
#define PB ((bf16_t*)(ws + WS_PB))
#define Eb ((bf16_t*)(ws + WS_E))
#define OUT (args.out)
#define SS(k) ((float*)(ws + 65536 + (size_t)(k) * M * 4))
#define H16A ((bf16_t*)args.out)
#define H16B ((bf16_t*)(ws + WS_XN))
    const int lo = args.ph_lo, hi = args.ph_hi;
#define IN(k) (lo <= (k) && (k) < hi)
#define REP(k) for (int rep_ = 0; rep_ < 1 + ((DUP_MASK >> (k)) & 1); ++rep_)
#if MK_N_LAUNCHES == 1
    volatile LAS unsigned* MISC = (volatile LAS unsigned*)(lds + LDS_BYTES - 256);
    if (tid < 64) MISC[tid] = 0u;
    __syncthreads();
    const XcdBarrier xbar = xcd_barrier_post((unsigned*)ws, MISC + 8);
    if (tid == 0) MISC[16] = xb_add((unsigned*)ws + XL_CNT(xbar.x < 8u ? xbar.x : 8u), 1u);
    __syncthreads();
    const unsigned xrank = (unsigned)__builtin_amdgcn_readfirstlane((int)MISC[16]);
    bool xl = false; int vc = (int)blockIdx.x;
#define SEAM(k) do { if (IN(k) && IN((k) + 1)) { if ((k) == 0) grid.sync(); else if (xl && (k) != 3 && (k) != 6 && (k) != 12) xl_barrier((unsigned*)ws, xbar.x, 32u); else xcd_barrier(xbar); } } while (0)
#else
#define SEAM(k) do { } while (0)
#endif

    if (IN(0)) REP(0) {
        LAS float* scr = (LAS float*)(lds + wave * 16384);
        constexpr int I_GU = (DM / 64) * (FF / 32), I_D = (FF / 64) * (DM / 32), I_QKV = (DM / 64) * (NQKV / 32), I_SQ = (DM / 64) * (DM / 32), I_PP = (PLE / 64) * (DM / 32);
        constexpr int NITEMS = 4 * I_GU + 2 * I_D + I_QKV + 2 * I_SQ + I_PP;
#define P0_DECODE(it_, d_) do { int r = (it_); \
            if (r < I_GU) { d_ = P0Item{args.in[I_W1G], W1GU, args.in[I_G1PRE], DM, FF, 1, r}; break; } r -= I_GU; \
            if (r < I_GU) { d_ = P0Item{args.in[I_W1U], W1GU, args.in[I_G1PRE], DM, FF, 2, r}; break; } r -= I_GU; \
            if (r < I_GU) { d_ = P0Item{args.in[I_W2G], W2GU, args.in[I_G2PRE], DM, FF, 1, r}; break; } r -= I_GU; \
            if (r < I_GU) { d_ = P0Item{args.in[I_W2U], W2GU, args.in[I_G2PRE], DM, FF, 2, r}; break; } r -= I_GU; \
            if (r < I_D) { d_ = P0Item{args.in[I_W1D], W1D, nullptr, FF, DM, 0, r}; break; } r -= I_D; \
            if (r < I_D) { d_ = P0Item{args.in[I_W2D], W2D, nullptr, FF, DM, 0, r}; break; } r -= I_D; \
            if (r < I_QKV) { d_ = P0Item{args.in[I_WQKV], WQKV, args.in[I_GMIXPRE], DM, NQKV, 0, r}; break; } r -= I_QKV; \
            if (r < I_SQ) { d_ = P0Item{args.in[I_WO], WO, nullptr, DM, DM, 0, r}; break; } r -= I_SQ; \
            if (r < I_SQ) { d_ = P0Item{args.in[I_WPG], WG, args.in[I_GPLEPRE], DM, DM, 0, r}; break; } r -= I_SQ; \
            d_ = P0Item{args.in[I_WPP], WP, nullptr, PLE, DM, 0, r}; } while (0)
        { float wa[32], wb[32]; P0Item da, db; int it = gw;
          if (it < NITEMS) { P0_DECODE(it, da); p0_load(da, wa, lane); }
          while (it < NITEMS) {
              const int i1 = it + NGW, i2 = i1 + NGW;
              if (i1 < NITEMS) { P0_DECODE(i1, db); p0_load(db, wb, lane); }
              p0_store(da, wa, scr, lane);
              if (i1 >= NITEMS) break;
              if (i2 < NITEMS) { P0_DECODE(i2, da); p0_load(da, wa, lane); }
              p0_store(db, wb, scr, lane);
              it = i2;
          } }
#undef P0_DECODE
        rms_rows(args.in[I_X], SS(0), XN, gw, NGW, lane);
        const float* P = args.in[I_P];
        for (size_t i = (size_t)blockIdx.x * 512 + tid; i < (size_t)M * PLE / 8; i += (size_t)G * 512) {
            const f32x4 a = ((const f32x4*)P)[2 * i], b = ((const f32x4*)P)[2 * i + 1];
            u32x4 w; w.x = cvt_pk_bf16(a.x, a.y); w.y = cvt_pk_bf16(a.z, a.w); w.z = cvt_pk_bf16(b.x, b.y); w.w = cvt_pk_bf16(b.z, b.w);
            ((u32x4*)PB)[i] = w; }
        __syncthreads();
    }
    SEAM(0);
#if MK_N_LAUNCHES == 1
    if (IN(0) && IN(1) && G == 256) { bool ok = true;
#pragma unroll
        for (int j = 0; j < 8; ++j) ok = ok && (xb_ld((unsigned*)ws + XL_CNT(j)) == 32u);
        if (ok) { xl = true; vc = (int)(xbar.x + 8u * xrank); } }
#endif
    const int rw0 = xl ? 4096 * (vc & 7) + (vc >> 3) * 8 + wave : gw, rwS = xl ? 256 : NGW, rwE = xl ? 4096 * (vc & 7) + 4096 : M;
    if (IN(1)) REP(1) {
        { pg8::Gemm g{XN, W1GU, M, 2 * FF, DM}; pg8::StaticOrder S; S.init(M, 2 * FF, G, vc); pg8::EpiSwiGLU E{ACT, FF, SS(0)}; pg8::gemm_phase(lds, g, S, E); }
        { pg8::Gemm g{PB, WP, M, DM, PLE}; pg8::StaticOrder S; S.init(M, DM, G, vc); pg8::EpiBf16 E{Eb, DM, nullptr, nullptr}; pg8::gemm_phase(lds, g, S, E); }
    }
    SEAM(1);
    if (IN(2)) REP(2) { pg8::Gemm g{ACT, W1D, M, DM, FF}; pg8::StaticOrder S; S.init(M, DM, G, vc); pg8::EpiBf16 E{Fb, DM, nullptr, nullptr}; pg8::gemm_phase(lds, g, S, E); }
    SEAM(2);
    if (IN(3)) REP(3) rowpass<false, true>(Fb, args.in[I_G1POST], 0.5f, args.in[I_X], H16A, SS(1), rw0, rwS, lane, rwE);
    SEAM(3);
    if (IN(4)) REP(4) { pg8::Gemm g{H16A, WQKV, M, NQKV, DM}; pg8::StaticOrder S; S.init(M, NQKV, G, vc); pg8::EpiBf16 E{Zb, NQKV, args.in[I_BQKV], SS(1)}; pg8::gemm_phase(lds, g, S, E); }
    SEAM(4);
    if (IN(5)) REP(5) attn_phase(lds, Zb, OA, LSE, OB, args.in[I_SINKS], G, vc, xl);
    SEAM(5);
    if (IN(6)) REP(6) combine_rows(OA, LSE, OB, args.in[I_GOA], args.in[I_GOB], XN, rw0, rwS, lane, rwE);
    SEAM(6);
    if (IN(7)) REP(7) { pg8::Gemm g{XN, WO, M, DM, DM}; pg8::StaticOrder S; S.init(M, DM, G, vc); pg8::EpiBf16 E{Fb, DM, args.in[I_BO], nullptr}; pg8::gemm_phase(lds, g, S, E); }
    SEAM(7);
    if (IN(8)) REP(8) rowpass<true, true>(Fb, args.in[I_GMIXPOST], 1.0f, H16A, H16A, SS(2), rw0, rwS, lane, rwE);
    SEAM(8);
    if (IN(9)) REP(9) { pg8::Gemm g{H16A, W2GU, M, 2 * FF, DM}; pg8::StaticOrder S; S.init(M, 2 * FF, G, vc); pg8::EpiSwiGLU E{ACT, FF, SS(2)}; pg8::gemm_phase(lds, g, S, E); }
    SEAM(9);
    if (IN(10)) REP(10) { pg8::Gemm g{ACT, W2D, M, DM, FF}; pg8::StaticOrder S; S.init(M, DM, G, vc); pg8::EpiBf16 E{Fb, DM, nullptr, nullptr}; pg8::gemm_phase(lds, g, S, E); }
    SEAM(10);
    if (IN(11)) REP(11) rowpass<true, true>(Fb, args.in[I_G2POST], 0.5f, H16A, H16B, SS(3), rw0, rwS, lane, rwE);
    SEAM(11);
    if (IN(12)) REP(12) { pg8::Gemm g{H16B, WG, M, DM, DM}; pg8::StaticOrder S; S.init(M, DM, G, vc); pg8::EpiSigMul E{Fb, Eb, DM, SS(3)}; pg8::gemm_phase(lds, g, S, E); }
    SEAM(12);
    if (IN(13)) REP(13) rowpass<true, false>(Fb, args.in[I_GPLEPOST], 1.0f, H16B, OUT, nullptr, rw0, rwS, lane, rwE);
#undef IN
#undef REP
#undef SEAM
}

extern "C" void kernel_launch(void* const* d_in, const int* in_sizes, int n_in, void* d_out, int out_size, void* d_ws, size_t ws_size, hipStream_t stream) {
    static int grid = 0;
    if (grid == 0) {
        if (n_in != N_IN || in_sizes[0] != M * DM || out_size != M * DM || ws_size < WS_END) { fprintf(stderr, "kernel_launch: unexpected problem: n_in %d in0 %d out %d ws %zu (need %zu)\n", n_in, n_in > 0 ? in_sizes[0] : -1, out_size, ws_size, (size_t)WS_END); grid = -1; return; }
        int dev = 0, cus = 0, per_cu = 0;
        if (hipGetDevice(&dev) != hipSuccess || hipDeviceGetAttribute(&cus, hipDeviceAttributeMultiprocessorCount, dev) != hipSuccess) { grid = -1; return; }
        if (hipFuncSetAttribute((const void*)mk_fwd, hipFuncAttributeMaxDynamicSharedMemorySize, LDS_BYTES) != hipSuccess) { fprintf(stderr, "kernel_launch: hipFuncSetAttribute failed\n"); grid = -1; return; }
        if (hipOccupancyMaxActiveBlocksPerMultiprocessor(&per_cu, (const void*)mk_fwd, 512, LDS_BYTES) != hipSuccess || per_cu < 1) { fprintf(stderr, "kernel_launch: occupancy query says %d\n", per_cu); per_cu = 1; }
        (void)hipGetLastError();
        grid = cus * per_cu;
    }
    if (grid < 0) return;
    Args a{};
    for (int i = 0; i < N_IN; ++i) a.in[i] = (const float*)d_in[i];
    a.out = (float*)d_out; a.ws = (unsigned char*)d_ws;
#if MK_N_LAUNCHES == 1
    if (hipMemsetAsync(d_ws, 0, 32768, stream) != hipSuccess) { fprintf(stderr, "kernel_launch: memset failed\n"); return; }
    a.ph_lo = 0; a.ph_hi = N_PHASES;
    void* kargs[] = {&a};
    hipError_t e = hipLaunchCooperativeKernel((const void*)mk_fwd, dim3(grid), dim3(512), kargs, LDS_BYTES, stream);
    if (e != hipSuccess) fprintf(stderr, "kernel_launch: cooperative launch failed: %s (grid %d)\n", hipGetErrorString(e), grid);
#else
    for (int ph = 0; ph < N_PHASES; ++ph) { a.ph_lo = ph; a.ph_hi = ph + 1; hipLaunchKernelGGL(mk_fwd, dim3(grid), dim3(512), LDS_BYTES, stream, a); }
#endif
}
```
